# Optimizing an MI355X kernel written in HIP

```python
import jax, jax.numpy as jnp
from jax import lax
import numpy as np

D_MODEL = 2048
BATCH = 16
SEQ = 2048
DEPTH = 4

D_FF = 4 * D_MODEL
CONV_WIDTH = 3
N_HEADS = 16
QK_HEAD_DIM = 128
V_HEAD_DIM = 128
Q_LORA = 512
KV_LORA = 256
IDX_HEADS = 16
IDX_DIM = 64
TOPK_MAX = 256
Q_BLOCK = 64
ATTN_SCALE = QK_HEAD_DIM ** -0.5
IN_COLS = Q_LORA + KV_LORA + IDX_DIM + IDX_HEADS
EPS = 1e-6
N_CONV = (DEPTH + 1) // 2
N_ATTN = DEPTH // 2

kernel_name = "hybrid_shortconv_dsa_sqrelu"


def rmsnorm(x, g):
    xf = x.astype(jnp.float32)
    y = xf * lax.rsqrt(jnp.mean(xf * xf, axis=-1, keepdims=True) + EPS)
    return (y * g.astype(jnp.float32)).astype(x.dtype)


def layernorm(x, g, b):
    xf = x.astype(jnp.float32)
    mu = jnp.mean(xf, axis=-1, keepdims=True)
    var = jnp.mean(jnp.square(xf - mu), axis=-1, keepdims=True)
    y = (xf - mu) * lax.rsqrt(var + EPS)
    return y * g.astype(jnp.float32) + b.astype(jnp.float32)


def sq_relu_mlp(h, w1, w2):
    return jnp.square(jax.nn.relu(h @ w1)) @ w2


def short_conv_mixer(h, w_in, conv_w, w_out):
    bg, cg, xt = jnp.split(h @ w_in, 3, axis=-1)
    z = cg * xt
    zp = jnp.pad(z, ((0, 0), (CONV_WIDTH - 1, 0), (0, 0)))
    s = z.shape[1]
    zc = conv_w[0] * zp[:, 0:s] + conv_w[1] * zp[:, 1:s + 1] + conv_w[2] * zp[:, 2:s + 2]
    return (bg * zc) @ w_out


def dsa_mixer(h, w_in, q_g, kv_g, w_uq, w_uk, w_uv, w_qidx, ln_g, ln_b, w_out):
    b, s, _ = h.shape
    topk = min(TOPK_MAX, s // 4)
    proj = h @ w_in
    c_q, c_kv, k_idx, w_idx = jnp.split(
        proj, [Q_LORA, Q_LORA + KV_LORA, Q_LORA + KV_LORA + IDX_DIM], axis=-1)
    c_q = rmsnorm(c_q, q_g)
    c_kv = rmsnorm(c_kv, kv_g)
    k_idx = layernorm(k_idx, ln_g, ln_b)
    w_idx = w_idx.astype(jnp.float32) * (IDX_HEADS ** -0.5 * IDX_DIM ** -0.5)
    nb = s // Q_BLOCK
    key_pos = jnp.arange(s, dtype=jnp.int32)

    def to_blocks(a):
        return a.reshape(b, nb, Q_BLOCK, *a.shape[2:]).swapaxes(0, 1)

    def block(args):
        cq, wi, t = args
        q = jnp.einsum('bqr,rhd->bqhd', cq, w_uq)
        q_lat = jnp.einsum('bqhd,hdc->bqhc', q, w_uk)
        q_idx = jnp.einsum('bqr,rhe->bqhe', cq, w_qidx).astype(jnp.float32)
        rel = jax.nn.relu(jnp.einsum('bqhe,bse->bqhs', q_idx, k_idx))
        score = jnp.einsum('bqhs,bqh->bqs', rel, wi)
        causal = key_pos[None, :] <= t[:, None]
        score = jnp.where(causal[None], score, -jnp.inf)
        _, idx = lax.top_k(score, topk)
        kv_sel = jax.vmap(lambda c, i: c[i])(c_kv, idx)
        logits = jnp.einsum('bqhc,bqkc->bqhk', q_lat, kv_sel).astype(jnp.float32) * ATTN_SCALE
        valid = (idx <= t[None, :, None])[:, :, None, :]
        p = jax.nn.softmax(jnp.where(valid, logits, -jnp.inf), axis=-1).astype(h.dtype)
        o_lat = jnp.einsum('bqhk,bqkc->bqhc', p, kv_sel)
        o = jnp.einsum('bqhc,hcv->bqhv', o_lat, w_uv).reshape(b, Q_BLOCK, N_HEADS * V_HEAD_DIM)
        return o @ w_out

    out = lax.map(block, (to_blocks(c_q), to_blocks(w_idx), key_pos.reshape(nb, Q_BLOCK)))
    return out.swapaxes(0, 1).reshape(b, s, -1)


def setup_inputs(seed: int = 0) -> dict:
    key = jax.random.key(seed)
    ks = jax.random.split(key, 20)
    f32 = jnp.float32

    def nrm(k, shape, fan_in):
        return jax.random.normal(k, shape, f32) * (fan_in ** -0.5)

    def gain(k, shape):
        return 1.0 + 0.02 * jax.random.normal(k, shape, f32)

    return {
        "x": jax.random.normal(ks[0], (BATCH, SEQ, D_MODEL), f32),
        "norm_mix": gain(ks[1], (DEPTH, D_MODEL)),
        "norm_mlp": gain(ks[2], (DEPTH, D_MODEL)),
        "mlp_w1": nrm(ks[3], (DEPTH, D_MODEL, D_FF), D_MODEL),
        "mlp_w2": nrm(ks[4], (DEPTH, D_FF, D_MODEL), D_FF),
        "conv_in": nrm(ks[5], (N_CONV, D_MODEL, 3 * D_MODEL), D_MODEL),
        "conv_w": nrm(ks[6], (N_CONV, CONV_WIDTH, D_MODEL), CONV_WIDTH),
        "conv_out": nrm(ks[7], (N_CONV, D_MODEL, D_MODEL), D_MODEL),
        "attn_in": nrm(ks[8], (N_ATTN, D_MODEL, IN_COLS), D_MODEL),
        "q_norm": gain(ks[9], (N_ATTN, Q_LORA)),
        "kv_norm": gain(ks[10], (N_ATTN, KV_LORA)),
        "w_uq": nrm(ks[11], (N_ATTN, Q_LORA, N_HEADS, QK_HEAD_DIM), Q_LORA),
        "w_uk": nrm(ks[12], (N_ATTN, N_HEADS, QK_HEAD_DIM, KV_LORA), QK_HEAD_DIM),
        "w_uv": nrm(ks[13], (N_ATTN, N_HEADS, KV_LORA, V_HEAD_DIM), KV_LORA),
        "w_qidx": nrm(ks[14], (N_ATTN, Q_LORA, IDX_HEADS, IDX_DIM), Q_LORA),
        "kidx_ln_g": gain(ks[15], (N_ATTN, IDX_DIM)),
        "kidx_ln_b": 0.02 * jax.random.normal(ks[16], (N_ATTN, IDX_DIM), f32),
        "attn_out": nrm(ks[17], (N_ATTN, N_HEADS * V_HEAD_DIM, D_MODEL), N_HEADS * V_HEAD_DIM),
        "final_norm": gain(ks[18], (D_MODEL,)),
    }


def reference(x, norm_mix, norm_mlp, mlp_w1, mlp_w2, conv_in, conv_w, conv_out,
              attn_in, q_norm, kv_norm, w_uq, w_uk, w_uv, w_qidx, kidx_ln_g, kidx_ln_b,
              attn_out, final_norm):
    h = x
    for i in range(DEPTH):
        j = i // 2
        hn = rmsnorm(h, norm_mix[i])
        if i % 2 == 0:
            h = h + short_conv_mixer(hn, conv_in[j], conv_w[j], conv_out[j])
        else:
            h = h + dsa_mixer(hn, attn_in[j], q_norm[j], kv_norm[j], w_uq[j], w_uk[j],
                              w_uv[j], w_qidx[j], kidx_ln_g[j], kidx_ln_b[j], attn_out[j])
        h = h + sq_relu_mlp(rmsnorm(h, norm_mlp[i]), mlp_w1[i], mlp_w2[i])
    return rmsnorm(h, final_norm)
```

```cpp
#include <hip/hip_runtime.h>
#include <cstdio>
#include <cstdint>

#ifndef PG8_LAYOUT8
#define PG8_LAYOUT8 true
#endif
#ifndef ATT_RB
#define ATT_RB 4
#endif
#ifndef ATT_PB
#define ATT_PB 4
#endif
#ifndef GROUP_SEAMS
#define GROUP_SEAMS 1
#endif
#ifndef I8_CONV_FROM
#define I8_CONV_FROM 1
#endif
#ifndef FP8_AO
#define FP8_AO 1
#endif
#ifndef MK_ONE_LAUNCH
#define MK_ONE_LAUNCH 1
#endif

__device__ __forceinline__ int fresh_tid(int wave_s) { unsigned ones = 0xffffffffu; asm volatile("" : "+s"(ones)); return wave_s * 64 + (int)__builtin_amdgcn_mbcnt_hi(ones, __builtin_amdgcn_mbcnt_lo(ones, 0u)); }
namespace pg8 {
#define PG8_LAS __attribute__((address_space(3)))
typedef unsigned short bf16_t;
typedef short bf16x8 __attribute__((ext_vector_type(8)));
typedef float f32x4 __attribute__((ext_vector_type(4)));
typedef unsigned u32x4 __attribute__((ext_vector_type(4)));
typedef unsigned u32x2 __attribute__((ext_vector_type(2)));
typedef int v4i32 __attribute__((ext_vector_type(4)));
typedef int v8i32 __attribute__((ext_vector_type(8)));
constexpr int BM = 256, BK = 64, HALF = 128, HTB = HALF * BK * 2  , STAGE_BYTES = 8 * HTB, NXCD = 8, WGM = 8;

__host__ __device__ __forceinline__ int lds_byte(int r, int c) { const int st = (r >> 4) * 2 + (c >> 5), rr = r & 15, cc = c & 31, ob = rr * 64 + cc * 2; return st * 1024 + (ob ^ (((ob >> 9) & 1) << 5)); }
__host__ __device__ __forceinline__ void stage_rc(int b, int& R, int& C) { const int st = b / 1024, sb = b % 1024, swz = sb ^ (((sb >> 9) & 1) << 5); R = (st >> 1) * 16 + swz / 64; C = (st & 1) * 32 + (swz % 64) / 2; }
__host__ __device__ __forceinline__ int lds_byte8(int r, int c) { return (r >> 3) * 1024 + (r & 7) * 128 + (((c >> 3) ^ (r & 7)) * 16) + (c & 7) * 2; }
__host__ __device__ __forceinline__ void stage_rc8(int b, int& R, int& C) { const int sub = b / 1024, sb = b % 1024, rr = sb / 128, pos = (sb % 128) / 16; R = sub * 8 + rr; C = (pos ^ rr) * 8; }
__host__ __device__ __forceinline__ int perm32(int rho) { const int n = rho >> 4, i = rho & 15; return 8 * (i >> 2) + 4 * n + (i & 3); }

struct Unit { int pm, pn; };
struct Gemm { const bf16_t* A; const bf16_t* Bt; int M, N, K, lda, ldb, akoff; };

struct StaticOrder {
    int nM, nN, nwg, G, c;
    __host__ __device__ void init(int M, int N, int G_, int c_) { nM = M / BM; nN = N / BM; nwg = nM * nN; G = G_; c = c_; }
    __host__ __device__ bool next(int i, Unit& u) const {
        const long L = (long)i * G + c; if (L >= nwg) return false;
        int wgid = (int)L; { const int q = nwg / NXCD, r = nwg % NXCD, xcd = wgid % NXCD, off = wgid / NXCD; wgid = (xcd < r ? xcd * (q + 1) : r * (q + 1) + (xcd - r) * q) + off; }
        const int nig = WGM * nN, gid = wgid / nig, fm = gid * WGM, gsz = (nM - fm) < WGM ? (nM - fm) : WGM;
        u.pm = fm + ((wgid % nig) % gsz); u.pn = (wgid % nig) / gsz; return true;
    }
    __device__ __forceinline__ void a_ready(const Unit&) const {}
    __device__ __forceinline__ void done(const Unit&) const {}
};

__device__ __forceinline__ unsigned cvt_pk_bf16(float lo, float hi) { unsigned r; asm volatile("v_cvt_pk_bf16_f32 %0, %1, %2" : "=v"(r) : "v"(lo), "v"(hi)); return r; }

template <class Epi, class Sched, bool ALIGN_EPI = false, bool SP2 = false, bool LAYOUT8 = PG8_LAYOUT8, int ES = 2, bool I8 = false>
__device__ __forceinline__ void gemm_phase(PG8_LAS unsigned char* lds, const Gemm g, const Sched& S, const Epi& E, int wave_s) {
    const int tid = fresh_tid(wave_s);
    const int wid = __builtin_amdgcn_readfirstlane(tid >> 6), lane = tid & 63, wr = wid >> 2, wc = wid & 3, fr = lane & 15, fq = lane >> 4;
    constexpr bool FP8 = (ES == 1) && !I8; static_assert(ES == 2 || LAYOUT8, "1-byte operands use the line layout"); static_assert(!I8 || ES == 1, "int8 operands are 1 byte");
    const int K = g.K, nt = K / (ES == 1 ? 2 * BK : BK);
    unsigned voffA[2], voffB[2];
#pragma unroll
    for (int i = 0; i < 2; ++i) { int R, C; if (LAYOUT8) stage_rc8(tid * 16 + i * 8192, R, C); else stage_rc(tid * 16 + i * 8192, R, C); const int Rb = (Epi::BMAP == 2) ? (64 * (R >> 5) + 16 * ((R & 15) >> 2) + 4 * ((R >> 4) & 1) + (R & 3)) : (Epi::PERM ? ((R & ~31) + perm32(R & 31)) : R);
        voffA[i] = (unsigned)(R * g.lda * ES + C * 2); voffB[i] = (unsigned)(Rb * g.ldb * ES + C * 2); }
    const size_t kstep = (size_t)(BK * 2);
    const size_t hstepA = (size_t)HALF * g.lda * ES, hstepB = (size_t)((Epi::BMAP == 2) ? 8 : HALF) * g.ldb * ES;
    const size_t tstepA = 2 * hstepA, tstepB = (size_t)BM * g.ldb * ES;
    const size_t akb = (size_t)g.akoff * ES;
    const unsigned ldsw = (unsigned)wid * 1024u;
    const int aoffk[2] = {FP8 ? lds_byte8(wr * 64 + fr, 16 * fq) : LAYOUT8 ? lds_byte8(wr * 64 + fr, fq * 8) : lds_byte(wr * 64 + fr, fq * 8), FP8 ? lds_byte8(wr * 64 + fr, 16 * fq + 8) : LAYOUT8 ? lds_byte8(wr * 64 + fr, 32 + fq * 8) : lds_byte(wr * 64 + fr, fq * 8) + 1024};
    const int boffk[2] = {FP8 ? lds_byte8(wc * 32 + fr, 16 * fq) : LAYOUT8 ? lds_byte8(wc * 32 + fr, fq * 8) : lds_byte(wc * 32 + fr, fq * 8), FP8 ? lds_byte8(wc * 32 + fr, 16 * fq + 8) : LAYOUT8 ? lds_byte8(wc * 32 + fr, 32 + fq * 8) : lds_byte(wc * 32 + fr, fq * 8) + 1024};
#define PG8_SA(b, h) (((b) * 2 + (h)) * HTB)
#define PG8_SB(b, h) ((4 + (b) * 2 + (h)) * HTB)
#define PG8_STAGE(bufoff, gbase, voff) do { _Pragma("unroll") for (int _i = 0; _i < 2; ++_i) { asm volatile("" : "+v"((voff)[_i]));     \
        __builtin_amdgcn_global_load_lds((const unsigned*)((const char*)(gbase) + (voff)[_i]), (PG8_LAS unsigned*)(lds + (bufoff) + ldsw + _i * 8192), 16, 0, 0); } } while (0)
#define PG8_LD8(p0, p1) __builtin_shufflevector(*(const PG8_LAS v4i32*)(p0), *(const PG8_LAS v4i32*)(p1), 0, 1, 2, 3, 4, 5, 6, 7)
#define PG8_LDA(dst, b, h) do { if constexpr (FP8) { _Pragma("unroll") for (int m = 0; m < 4; ++m) dst##8[m] = PG8_LD8(lds + PG8_SA(b, h) + aoffk[0] + m * 2048, lds + PG8_SA(b, h) + aoffk[1] + m * 2048); } else { \
        _Pragma("unroll") for (int m = 0; m < 4; ++m) _Pragma("unroll") for (int k = 0; k < 2; ++k) dst[m][k] = *(const PG8_LAS bf16x8*)(lds + PG8_SA(b, h) + aoffk[k] + m * 2048); } } while (0)
#define PG8_LDB(dst, b, h) do { if constexpr (FP8) { _Pragma("unroll") for (int n = 0; n < 2; ++n) dst##8[n] = PG8_LD8(lds + PG8_SB(b, h) + boffk[0] + n * 2048, lds + PG8_SB(b, h) + boffk[1] + n * 2048); } else { \
        _Pragma("unroll") for (int n = 0; n < 2; ++n) _Pragma("unroll") for (int k = 0; k < 2; ++k) dst[n][k] = *(const PG8_LAS bf16x8*)(lds + PG8_SB(b, h) + boffk[k] + n * 2048); } } while (0)
#define PG8_MMA(ai, bj, At, Bt) do { __builtin_amdgcn_s_setprio(1); if constexpr (FP8) { _Pragma("unroll") for (int m = 0; m < 4; ++m) _Pragma("unroll") for (int n = 0; n < 2; ++n) \
        acc[ai][bj][m][n] = __builtin_amdgcn_mfma_scale_f32_16x16x128_f8f6f4(Bt##8[n], At##8[m], acc[ai][bj][m][n], 0, 0, 0, 0, 0, 0); } else { \
        _Pragma("unroll") for (int m = 0; m < 4; ++m) _Pragma("unroll") for (int n = 0; n < 2; ++n) _Pragma("unroll") for (int k = 0; k < 2; ++k) { \
        if constexpr (I8) acc[ai][bj][m][n] = __builtin_bit_cast(f32x4, __builtin_amdgcn_mfma_i32_16x16x64_i8(__builtin_bit_cast(v4i32, Bt[n][k]), __builtin_bit_cast(v4i32, At[m][k]), __builtin_bit_cast(v4i32, acc[ai][bj][m][n]), 0, 0, 0)); \
        else acc[ai][bj][m][n] = __builtin_amdgcn_mfma_f32_16x16x32_bf16(Bt[n][k], At[m][k], acc[ai][bj][m][n], 0, 0, 0); } } __builtin_amdgcn_s_setprio(0); } while (0)
#define PG8_WAIT_V(n) asm volatile("s_waitcnt vmcnt(" #n ")" ::: "memory")
#define PG8_WAIT_L(n) asm volatile("s_waitcnt lgkmcnt(" #n ")" ::: "memory")
#define PG8_BAR __builtin_amdgcn_s_barrier()
#define PG8_SCHED __builtin_amdgcn_sched_barrier(0)
    Unit cur, nxt; int ui = 0;
    if (!S.next(0, cur)) return;
    f32x4 acc[2][2][4][2];
#pragma unroll
    for (int a = 0; a < 2; ++a)
#pragma unroll
        for (int b = 0; b < 2; ++b)
#pragma unroll
            for (int m = 0; m < 4; ++m)
#pragma unroll
                for (int n = 0; n < 2; ++n) acc[a][b][m][n] = (f32x4){0.f, 0.f, 0.f, 0.f};
    bf16x8 At[4][2], B0[2][2], B1[2][2];
    v8i32 At8[4], B08[2], B18[2];
    const char* cA = (const char*)g.A + (size_t)cur.pm * tstepA + (size_t)cur.pn * akb; const char* cB = (const char*)g.Bt + (size_t)cur.pn * tstepB;
    S.a_ready(cur);
    if constexpr (SP2) {
        PG8_STAGE(PG8_SB(0, 0), cB, voffB); PG8_STAGE(PG8_SB(0, 1), cB + hstepB, voffB); PG8_STAGE(PG8_SA(0, 0), cA, voffA); PG8_STAGE(PG8_SA(0, 1), cA + hstepA, voffA);
        if (wr == 1) PG8_BAR;
        PG8_WAIT_V(2); PG8_BAR;
        PG8_STAGE(PG8_SB(1, 0), cB + kstep, voffB); PG8_STAGE(PG8_SA(1, 0), cA + kstep, voffA); PG8_STAGE(PG8_SB(1, 1), cB + hstepB + kstep, voffB);
        PG8_WAIT_V(6); PG8_BAR;
    } else {
        PG8_STAGE(PG8_SB(0, 0), cB, voffB); PG8_STAGE(PG8_SA(0, 0), cA, voffA); PG8_STAGE(PG8_SB(0, 1), cB + hstepB, voffB); PG8_STAGE(PG8_SA(0, 1), cA + hstepA, voffA);
        if (wr == 1) PG8_BAR;
        PG8_WAIT_V(4); PG8_BAR;
        PG8_STAGE(PG8_SB(1, 0), cB + kstep, voffB); PG8_STAGE(PG8_SA(1, 0), cA + kstep, voffA); PG8_STAGE(PG8_SB(1, 1), cB + hstepB + kstep, voffB);
        PG8_WAIT_V(6); PG8_BAR;
    }
    for (;;) {
        const bool has_next = S.next(ui + 1, nxt);
        const char* nA = has_next ? (const char*)g.A + (size_t)nxt.pm * tstepA + (size_t)nxt.pn * akb : cA; const char* nB = has_next ? (const char*)g.Bt + (size_t)nxt.pn * tstepB : cB;
        for (int t = 0; t < nt; t += 2) {
            const bool last = (t == nt - 2);
            const char* a1 = cA + (size_t)(t + 1) * kstep;
            const char* a2 = last ? nA : cA + (size_t)(t + 2) * kstep; const char* b2 = last ? nB : cB + (size_t)(t + 2) * kstep;
            const char* a3 = a2 + kstep; const char* b3 = b2 + kstep;
            if (last && has_next) S.a_ready(nxt);
            if constexpr (SP2) {
            PG8_LDB(B0, 0, 0); PG8_LDB(B1, 0, 1); PG8_SCHED; PG8_LDA(At, 0, 0); PG8_STAGE(PG8_SA(1, 1), a1 + hstepA, voffA);
            PG8_WAIT_V(8); PG8_WAIT_L(0); PG8_BAR; PG8_MMA(0, 0, At, B0); PG8_MMA(0, 1, At, B1); PG8_BAR; PG8_SCHED;
            PG8_LDA(At, 0, 1); PG8_STAGE(PG8_SB(0, 0), b2, voffB); PG8_STAGE(PG8_SB(0, 1), b2 + hstepB, voffB); PG8_STAGE(PG8_SA(0, 0), a2, voffA);
            PG8_WAIT_V(8); PG8_WAIT_L(0); PG8_BAR; PG8_MMA(1, 0, At, B0); PG8_MMA(1, 1, At, B1); PG8_BAR; PG8_SCHED;
            PG8_LDB(B0, 1, 0); PG8_LDB(B1, 1, 1); PG8_SCHED; PG8_LDA(At, 1, 0); PG8_STAGE(PG8_SA(0, 1), a2 + hstepA, voffA);
            PG8_WAIT_V(8); PG8_WAIT_L(0); PG8_BAR; PG8_MMA(0, 0, At, B0); PG8_MMA(0, 1, At, B1); PG8_BAR; PG8_SCHED;
            PG8_LDA(At, 1, 1); PG8_STAGE(PG8_SB(1, 0), b3, voffB); PG8_STAGE(PG8_SB(1, 1), b3 + hstepB, voffB); PG8_STAGE(PG8_SA(1, 0), a3, voffA);
            PG8_WAIT_V(8); PG8_WAIT_L(0); PG8_BAR; PG8_MMA(1, 0, At, B0); PG8_MMA(1, 1, At, B1); PG8_BAR; PG8_SCHED;
            } else {
            PG8_LDB(B0, 0, 0); PG8_SCHED; PG8_LDA(At, 0, 0); PG8_STAGE(PG8_SA(1, 1), a1 + hstepA, voffA);
            PG8_WAIT_L(8); PG8_BAR; PG8_WAIT_L(0); PG8_MMA(0, 0, At, B0); PG8_BAR; PG8_SCHED;
            PG8_LDB(B1, 0, 1); PG8_STAGE(PG8_SB(0, 0), b2, voffB);
            PG8_BAR; PG8_WAIT_L(0); PG8_MMA(0, 1, At, B1); PG8_BAR;
            PG8_LDA(At, 0, 1); PG8_STAGE(PG8_SA(0, 0), a2, voffA);
            PG8_BAR; PG8_WAIT_L(0); PG8_MMA(1, 0, At, B0); PG8_BAR; PG8_SCHED;
            PG8_STAGE(PG8_SB(0, 1), b2 + hstepB, voffB);
            PG8_WAIT_V(6); PG8_BAR; PG8_MMA(1, 1, At, B1); PG8_BAR;
            PG8_LDB(B0, 1, 0); PG8_SCHED; PG8_LDA(At, 1, 0); PG8_STAGE(PG8_SA(0, 1), a2 + hstepA, voffA);
            PG8_WAIT_L(8); PG8_BAR; PG8_WAIT_L(0); PG8_MMA(0, 0, At, B0); PG8_BAR; PG8_SCHED;
            PG8_LDB(B1, 1, 1); PG8_STAGE(PG8_SB(1, 0), b3, voffB);
            PG8_BAR; PG8_WAIT_L(0); PG8_MMA(0, 1, At, B1); PG8_BAR;
            PG8_LDA(At, 1, 1); PG8_STAGE(PG8_SA(1, 0), a3, voffA);
            PG8_BAR; PG8_WAIT_L(0); PG8_MMA(1, 0, At, B0); PG8_BAR; PG8_SCHED;
            PG8_STAGE(PG8_SB(1, 1), b3 + hstepB, voffB);
            PG8_WAIT_V(6); PG8_BAR; PG8_MMA(1, 1, At, B1); PG8_BAR;
            }
        }
        if constexpr (ALIGN_EPI) { if (wr == 0) PG8_BAR; }
        { const int l2 = fresh_tid(wave_s) & 63; E(acc, cur, wr, wc, l2 & 15, l2 >> 4); }
        S.done(cur);
        if (!has_next) break;
#pragma unroll
        for (int a = 0; a < 2; ++a)
#pragma unroll
            for (int b = 0; b < 2; ++b)
#pragma unroll
                for (int m = 0; m < 4; ++m)
#pragma unroll
                    for (int n = 0; n < 2; ++n) acc[a][b][m][n] = (f32x4){0.f, 0.f, 0.f, 0.f};
        cur = nxt; cA = nA; cB = nB; ++ui;
        if constexpr (ALIGN_EPI) { if (wr == 1) PG8_BAR; }
    }
    PG8_WAIT_V(0);
    if constexpr (!ALIGN_EPI) { if (wr == 0) PG8_BAR; }
    PG8_BAR;
#undef PG8_SA
#undef PG8_SB
#undef PG8_STAGE
#undef PG8_LDA
#undef PG8_LDB
#undef PG8_MMA
#undef PG8_LD8
#undef PG8_WAIT_V
#undef PG8_WAIT_L
#undef PG8_BAR
#undef PG8_SCHED
}
}

constexpr int NWAVES = 8, NTHR = NWAVES * 64;
constexpr int BATCH = 16, SEQ = 2048, DM = 2048, DEPTH = 4, FF = 8192;
constexpr int M = BATCH * SEQ;
constexpr int NHEAD = 16, QLORA = 512, KVL = 256, IDXD = 64, IDXH = 16, TOPK = 256, INC = 848, INCP = 1024;
constexpr int NQ = NHEAD * KVL + IDXH * IDXD;
constexpr float EPS = 1e-6f;
constexpr float QSCALE = 0.08838834764831845f * 1.4426950408889634f;

constexpr size_t MiB = 1u << 20;
constexpr size_t WS_CTL = 0, CTL_ZERO_BYTES = 4 * MiB;
constexpr size_t WS_RSS = 1 * MiB;
constexpr size_t WS_SBW = 3 * MiB + 768 * 1024;
constexpr size_t WS_WCA = 4 * MiB;
constexpr size_t WS_WCB = WS_WCA + 16 * MiB, WS_WCO = WS_WCA + 24 * MiB, CONV_W_STRIDE = 32 * MiB;
constexpr size_t WS_W1 = 68 * MiB, W1_STRIDE = 16 * MiB, WS_W2 = 132 * MiB, W2_STRIDE = 32 * MiB;
constexpr size_t WS_X8 = 260 * MiB;
constexpr size_t WS_WAI = 324 * MiB;
constexpr size_t WS_WQ = WS_WAI + 4 * MiB, WS_WUV = WS_WAI + 9 * MiB, WS_WAO = WS_WAI + 11 * MiB, ATT_W_STRIDE = 19 * MiB;
constexpr size_t WS_HB = 362 * MiB;
constexpr size_t WS_BIG = 490 * MiB;
constexpr size_t WS_A1 = WS_BIG;
constexpr size_t WS_Z = WS_BIG, WS_U = WS_BIG + 128 * MiB;
constexpr size_t WS_PROJ = WS_BIG;
constexpr size_t WS_O = WS_BIG + 384 * MiB;
static_assert(FP8_AO == 1, "the bf16 O buffer would not fit over q_idx");
constexpr size_t WS_QLAT = WS_BIG + 128 * MiB;
constexpr size_t WS_QIDX = WS_QLAT + 256 * MiB;
constexpr size_t WS_CQN = WS_QIDX + 64 * MiB;
constexpr size_t WS_CKV = WS_CQN + 32 * MiB;
constexpr size_t WS_KIDX = WS_CKV + 16 * MiB;
constexpr size_t WS_WIDX = WS_KIDX + 4 * MiB;
constexpr size_t WS_IDX = WS_WIDX + 2 * MiB;
constexpr size_t WS_END = 1024 * MiB;
static_assert(WS_IDX + 16 * MiB <= WS_END && WS_A1 + 512 * MiB <= WS_END && WS_WAI + 2 * ATT_W_STRIDE <= WS_HB && WS_W1 + 4 * W1_STRIDE <= WS_W2 && WS_W2 + 4 * W2_STRIDE <= WS_X8 && WS_X8 + 64 * MiB <= WS_WAI && WS_WCA + 2 * CONV_W_STRIDE <= WS_W1, "d_ws map");
constexpr int CW_TMO = 0, CW_CODE = 1, CW_BAR = 4096;

constexpr int LDS_PHASE_BYTES = 151552;
constexpr int LDSCTL_OFF = LDS_PHASE_BYTES, LDS_BYTES = LDSCTL_OFF + 512;

#define GAS __attribute__((address_space(1)))
#define LAS __attribute__((address_space(3)))
typedef unsigned short bf16;
typedef unsigned v4u __attribute__((ext_vector_type(4)));
typedef unsigned v2u __attribute__((ext_vector_type(2)));
typedef float f32x4 __attribute__((ext_vector_type(4)));
typedef GAS unsigned gu32;
#define RLX_AGENT __ATOMIC_RELAXED, __HIP_MEMORY_SCOPE_AGENT
#define LDS_WAIT() asm volatile("s_waitcnt lgkmcnt(0)" ::: "memory")
#define VM_WAIT() asm volatile("s_waitcnt vmcnt(0)" ::: "memory")
__device__ __forceinline__ unsigned f2bf(float f) { unsigned u = __builtin_bit_cast(unsigned, f); return (u + 0x7fffu + ((u >> 16) & 1u)) >> 16; }
__device__ __forceinline__ unsigned pk2(float lo, float hi) { return f2bf(lo) | (f2bf(hi) << 16); }
__device__ __forceinline__ float bflo(unsigned w) { return __builtin_bit_cast(float, w << 16); }
__device__ __forceinline__ float bfhi(unsigned w) { return __builtin_bit_cast(float, w & 0xffff0000u); }
__device__ __forceinline__ float bf2f(bf16 h) { return __builtin_bit_cast(float, (unsigned)h << 16); }

#define XB_TMO      128
#define XB_XCNT(j)  (256  + 64 * (j))
#define XB_XSUB(j)  (1280 + 64 * (j))
#define XB_XGEN(j)  (2304 + 64 * (j))
#define XB_TOP      3328
#define XB_TOPGEN   3392
#define XCD_BAR_WORDS 3456
#define XB_SPIN_CAP (1u << 18)
__device__ __forceinline__ unsigned xb_ld(unsigned* p)              { return __hip_atomic_load(p, __ATOMIC_RELAXED, __HIP_MEMORY_SCOPE_AGENT); }
__device__ __forceinline__ unsigned xb_add(unsigned* p, unsigned v) { return __hip_atomic_fetch_add(p, v, __ATOMIC_RELAXED, __HIP_MEMORY_SCOPE_AGENT); }
__device__ __forceinline__ unsigned xb_xcc_id() { return (unsigned)__builtin_amdgcn_s_getreg((3 << 11) | 20) & 0xFu; }
#define XB_SPIN(cond, bar) do { unsigned _sp = 0; while (cond) { __builtin_amdgcn_s_sleep(1); \
    if ((++_sp & 255u) == 0u) { if (xb_ld(&(bar)[XB_TMO])) break; if (_sp > XB_SPIN_CAP) { atomicAdd(&(bar)[XB_TMO], 1u); break; } } } } while (0)
struct XcdBarrier { unsigned* bar; unsigned x; volatile LAS unsigned* st; int wave_s; };
__device__ __forceinline__ XcdBarrier xcd_barrier_post(unsigned* bar, volatile LAS unsigned* st, int wave_s) {
    XcdBarrier b; b.bar = bar; b.x = xb_xcc_id(); b.st = st; b.wave_s = wave_s;
    if (fresh_tid(wave_s) == 0) (void)xb_add(&bar[XB_XCNT(b.x)], 1u);
    return b;
}
__device__ __forceinline__ void xcd_barrier_complete(unsigned* bar, unsigned x, unsigned& nloc, unsigned& nx) {
    const unsigned G = gridDim.x * gridDim.y * gridDim.z;
    unsigned sum, cnt, mine, sp = 0u;
    for (;;) {
        sum = 0u; cnt = 0u; mine = 0u;
#pragma unroll
        for (unsigned j = 0; j < 16; ++j) { const unsigned c = xb_ld(&bar[XB_XCNT(j)]); sum += c; cnt += (c > 0u) ? 1u : 0u; mine = (j == x) ? c : mine; }
        if (sum == G) break;
        __builtin_amdgcn_s_sleep(1);
        if ((++sp & 255u) == 0u) { if (xb_ld(&bar[XB_TMO])) break; if (sp > XB_SPIN_CAP) { atomicAdd(&bar[XB_TMO], 1u); break; } }
    }
    nloc = mine > 0u ? mine : 1u; nx = cnt > 0u ? cnt : 1u;
}
__device__ __forceinline__ void xcd_barrier(const XcdBarrier& b) {
    asm volatile("s_waitcnt vmcnt(0)" ::: "memory");
    __syncthreads();
    if (fresh_tid(b.wave_s) == 0) {
        unsigned* bar = b.bar;
        __builtin_amdgcn_s_waitcnt(0);
        unsigned nloc = b.st[0], nx = b.st[1];
        if (nloc == 0u) { xcd_barrier_complete(bar, b.x, nloc, nx); b.st[0] = nloc; b.st[1] = nx; }
        const unsigned old = xb_add(&bar[XB_XSUB(b.x)], 1u);
        const unsigned gen = old / nloc;
        if (old + 1u == (gen + 1u) * nloc) {
            __builtin_amdgcn_fence(__ATOMIC_RELEASE, "agent");
            asm volatile("s_waitcnt vmcnt(0)" ::: "memory");
            const unsigned og = xb_add(&bar[XB_TOP], 1u);
            const unsigned tg = og / nx;
            if (og + 1u == (tg + 1u) * nx) xb_add(&bar[XB_TOPGEN], 1u);
            else XB_SPIN(xb_ld(&bar[XB_TOPGEN]) == tg, bar);
            __builtin_amdgcn_fence(__ATOMIC_ACQUIRE, "agent");
            xb_add(&bar[XB_XGEN(b.x)], 1u);
            asm volatile("s_waitcnt vmcnt(0)" ::: "memory");
        } else {
            XB_SPIN(xb_ld(&bar[XB_XGEN(b.x)]) == gen, bar);
            __builtin_amdgcn_fence(__ATOMIC_ACQUIRE, "agent");
            asm volatile("s_waitcnt vmcnt(0)" ::: "memory");
        }
    }
    __syncthreads();
}

#define GB_WORD(g) (XCD_BAR_WORDS + 128 + 64 * (g))
__device__ __forceinline__ void grp_barrier(unsigned* bar, int grp, int wave_s) {
    asm volatile("s_waitcnt vmcnt(0)" ::: "memory");
    __syncthreads();
    if (fresh_tid(wave_s) == 0) {
        unsigned* cnt = bar + GB_WORD(grp);
        __builtin_amdgcn_fence(__ATOMIC_RELEASE, "agent");
        asm volatile("s_waitcnt vmcnt(0)" ::: "memory");
        const unsigned old = xb_add(cnt, 1u), target = (old / 32u + 1u) * 32u;
        XB_SPIN(xb_ld(cnt) < target, bar);
        __builtin_amdgcn_fence(__ATOMIC_ACQUIRE, "agent");
        asm volatile("s_waitcnt vmcnt(0)" ::: "memory");
    }
    __syncthreads();
}

#define XL_CNT(x) (XCD_BAR_WORDS + 1024 + 64 * (x))
#define XL_GEN(x) (XCD_BAR_WORDS + 2048 + 64 * (x))
#define XL_TAB    (XCD_BAR_WORDS + 3072)
__device__ __forceinline__ void grp_barrier_fast(unsigned* bar, unsigned x, int wave_s) {
    asm volatile("s_waitcnt vmcnt(0)" ::: "memory");
    __syncthreads();
    if (fresh_tid(wave_s) == 0) {
        const unsigned old = xb_add(&bar[XL_CNT(x)], 1u), gen = old / 32u;
        if (old + 1u == (gen + 1u) * 32u) {
            __builtin_amdgcn_fence(__ATOMIC_ACQUIRE, "agent");
            xb_add(&bar[XL_GEN(x)], 1u);
            asm volatile("s_waitcnt vmcnt(0)" ::: "memory");
        } else {
            XB_SPIN(xb_ld(&bar[XL_GEN(x)]) == gen, bar);
            __builtin_amdgcn_fence(__ATOMIC_ACQUIRE, "agent");
            asm volatile("s_waitcnt vmcnt(0)" ::: "memory");
        }
    }
    __syncthreads();
}

using pg8::Unit; using pg8::cvt_pk_bf16; using pg8::HALF;
typedef pg8::f32x4 accT[2][2][4][2];
typedef unsigned long long rss_t;
constexpr float RSS_SCALE = 16777216.0f;
__device__ __forceinline__ float rstd_raw(rss_t v) { return rsqrtf((float)v * (1.0f / (RSS_SCALE * DM)) + EPS); }
__device__ __forceinline__ float ms_raw(rss_t v) { return (float)v * (1.0f / (RSS_SCALE * DM)) + EPS; }
__device__ __forceinline__ float rstd_of(const rss_t* rss, int r) { return rsqrtf((float)rss[r] * (1.0f / (RSS_SCALE * DM)) + EPS); }

__device__ __forceinline__ unsigned pk4_fp8(float a, float b, float c, float d) { int w = 0; w = __builtin_amdgcn_cvt_pk_fp8_f32(a, b, w, false); w = __builtin_amdgcn_cvt_pk_fp8_f32(c, d, w, true); return (unsigned)w; }
constexpr float QC = 22.0f, WCLIP = 4.2f;
__device__ __forceinline__ float ms_of(const rss_t* rss, int r) { return (float)rss[r] * (1.0f / (RSS_SCALE * DM)) + EPS; }
__device__ __forceinline__ unsigned pk4_i8(float a, float b, float c, float d) {
    unsigned w = 0;
    w = __builtin_amdgcn_cvt_pk_u8_f32(a + 128.0f, 0, w); w = __builtin_amdgcn_cvt_pk_u8_f32(b + 128.0f, 1, w);
    w = __builtin_amdgcn_cvt_pk_u8_f32(c + 128.0f, 2, w); w = __builtin_amdgcn_cvt_pk_u8_f32(d + 128.0f, 3, w);
    return w ^ 0x80808080u;
}
constexpr float HCLIP = 20.0f;
struct EpiRelu2H8 {
    static constexpr bool PERM = true; static constexpr int BMAP = 2;
    unsigned char* O; int ldc; const rss_t* rss; const rss_t* rss_q; const float* sbw; LAS unsigned char* cache;
    __device__ __forceinline__ void operator()(const accT& acc, const Unit& u, int wr, int wc, int fr, int fq) const {
        const int row0 = u.pm * 256 + wr * 64 + fr, col0 = u.pn * 256 + 64 * wc + 16 * fq; float kc = 3.570714214f / QC; asm volatile("" : "+s"(kc));
        const float sb = *sbw * kc;
        const int l64 = (fr + 16 * fq) & 63; LAS float* slot = (LAS float*)(cache + 32 * l64); LAS int* tagp = (LAS int*)(cache + 2048);
        float rs8[2][4];
        if (__builtin_amdgcn_readfirstlane(*tagp) != u.pm) {
            rss_t ra[2][4], rb[2][4];
#pragma unroll
            for (int ai = 0; ai < 2; ++ai)
#pragma unroll
                for (int m = 0; m < 4; ++m) { const int r = row0 + ai * HALF + m * 16; ra[ai][m] = rss[r]; rb[ai][m] = rss_q[r]; }
            __builtin_amdgcn_sched_barrier(0);
#pragma unroll
            for (int ai = 0; ai < 2; ++ai)
#pragma unroll
                for (int m = 0; m < 4; ++m) rs8[ai][m] = rstd_raw(ra[ai][m]) * sqrtf(ms_raw(rb[ai][m])) * sb;
            *(LAS f32x4*)slot = (f32x4){rs8[0][0], rs8[0][1], rs8[0][2], rs8[0][3]}; *(LAS f32x4*)(slot + 4) = (f32x4){rs8[1][0], rs8[1][1], rs8[1][2], rs8[1][3]};
            *tagp = u.pm;
        } else {
            const f32x4 c0 = *(const LAS f32x4*)slot, c1 = *(const LAS f32x4*)(slot + 4);
#pragma unroll
            for (int m = 0; m < 4; ++m) { rs8[0][m] = c0[m]; rs8[1][m] = c1[m]; }
        }
#pragma unroll
        for (int ai = 0; ai < 2; ++ai) {
            float rsv[4];
#pragma unroll
            for (int m = 0; m < 4; ++m) rsv[m] = rs8[ai][m];
#pragma unroll
            for (int m = 0; m < 4; ++m) { const int r = row0 + ai * HALF + m * 16; const float rs = rsv[m]; unsigned wd[4];
#pragma unroll
                for (int bj = 0; bj < 2; ++bj)
#pragma unroll
                    for (int n = 0; n < 2; ++n) { const pg8::f32x4 a4 = acc[ai][bj][m][n]; float q[4];
#pragma unroll
                        for (int e = 0; e < 4; ++e) { const float x = a4[e]; const float v = (float)__float_as_int(x) * rs; q[e] = v * fmaxf(v, 0.f); }
                        unsigned w = 0; w = __builtin_amdgcn_cvt_pk_u8_f32(q[0], 0, w); w = __builtin_amdgcn_cvt_pk_u8_f32(q[1], 1, w); w = __builtin_amdgcn_cvt_pk_u8_f32(q[2], 2, w); w = __builtin_amdgcn_cvt_pk_u8_f32(q[3], 3, w);
                        wd[2 * bj + n] = w ^ 0x80808080u; }
                *(pg8::u32x4*)(O + (size_t)r * ldc + col0) = (pg8::u32x4){wd[0], wd[1], wd[2], wd[3]}; }
            asm volatile("" ::: "memory");
        }
    }
};
struct EpiF8 {
    static constexpr bool PERM = true; static constexpr int BMAP = 2;
    unsigned char* O; int ldc; float sc;
    __device__ __forceinline__ void operator()(const accT& acc, const Unit& u, int wr, int wc, int fr, int fq) const {
        const int row0 = u.pm * 256 + wr * 64 + fr, col0 = u.pn * 256 + 64 * wc + 16 * fq;
#pragma unroll
        for (int ai = 0; ai < 2; ++ai)
#pragma unroll
            for (int m = 0; m < 4; ++m) { const int r = row0 + ai * HALF + m * 16; unsigned wd[4];
#pragma unroll
                for (int bj = 0; bj < 2; ++bj)
#pragma unroll
                    for (int n = 0; n < 2; ++n) { const pg8::f32x4 v = acc[ai][bj][m][n] * sc; wd[2 * bj + n] = pk4_fp8(v[0], v[1], v[2], v[3]); }
                *(pg8::u32x4*)(O + (size_t)r * ldc + col0) = (pg8::u32x4){wd[0], wd[1], wd[2], wd[3]}; }
    }
};
template <bool ACCI> __device__ __forceinline__ pg8::f32x4 acc_f(const pg8::f32x4 a) {
    if constexpr (ACCI) { const float x0 = a[0], x1 = a[1], x2 = a[2], x3 = a[3]; return (pg8::f32x4){(float)__float_as_int(x0), (float)__float_as_int(x1), (float)__float_as_int(x2), (float)__float_as_int(x3)}; }
    else return a;
}
constexpr float CQSC = 127.0f / 5.5f;
template <bool RS, bool ACCI = false> struct EpiBf16T {
    static constexpr bool PERM = true; static constexpr int BMAP = 1;
    bf16* O; int ldc; bf16* O2; int ldc2; int split; const rss_t* rsq = nullptr; const float* step1 = nullptr; const float* step2 = nullptr;
    __device__ __forceinline__ void operator()(const accT& acc, const Unit& u, int wr, int wc, int fr, int fq) const {
        if constexpr (ACCI) asm volatile("" ::: "memory");
        int colt = u.pn * 256; bf16* base = O; int ld = ldc; float cst = 1.0f; if constexpr (ACCI) cst = *step1 * (1.0f / CQSC);
        if (colt >= split) { colt -= split; base = O2; ld = ldc2; if constexpr (ACCI) cst = *step2 * (1.0f / CQSC); }
        const int row0 = u.pm * 256 + wr * 64 + fr, col0 = colt + wc * 32 + 8 * fq;
        float rsv[2][4]; rss_t rraw[2][4];
#pragma unroll
        for (int ai = 0; ai < 2; ++ai)
#pragma unroll
            for (int m = 0; m < 4; ++m) { rsv[ai][m] = cst; if constexpr (RS) rraw[ai][m] = rsq[row0 + ai * HALF + m * 16]; }
        if constexpr (RS) { __builtin_amdgcn_sched_barrier(0);
#pragma unroll
            for (int ai = 0; ai < 2; ++ai)
#pragma unroll
                for (int m = 0; m < 4; ++m) rsv[ai][m] *= rsqrtf((float)rraw[ai][m] * (1.0f / (RSS_SCALE * QLORA)) + EPS); }
#pragma unroll
        for (int ai = 0; ai < 2; ++ai)
#pragma unroll
            for (int m = 0; m < 4; ++m) { bf16* rowp = base + (size_t)(row0 + ai * HALF + m * 16) * ld + col0;
                const float rs = rsv[ai][m];
#pragma unroll
                for (int bj = 0; bj < 2; ++bj) { pg8::f32x4 v0 = acc_f<ACCI>(acc[ai][bj][m][0]), v1 = acc_f<ACCI>(acc[ai][bj][m][1]); if constexpr (RS || ACCI) { v0 = v0 * rs; v1 = v1 * rs; }
                    pg8::u32x4 w; w.x = cvt_pk_bf16(v0[0], v0[1]); w.y = cvt_pk_bf16(v0[2], v0[3]); w.z = cvt_pk_bf16(v1[0], v1[1]); w.w = cvt_pk_bf16(v1[2], v1[3]);
                    *(pg8::u32x4*)(rowp + bj * HALF) = w; } }
    }
};
typedef EpiBf16T<false> EpiBf16; typedef EpiBf16T<true> EpiBf16S; typedef EpiBf16T<true, true> EpiBf16SI;
template <bool ACCI> __device__ __forceinline__ float rowf(const rss_t* rss, const rss_t* rss_q, int r) {
    float f = rstd_of(rss, r); if constexpr (ACCI) f *= sqrtf(ms_of(rss_q, r)) * (1.0f / QC); return f;
}
template <bool ACCI> struct EpiRowScaleF32T {
    static constexpr bool PERM = false; static constexpr int BMAP = 0;
    float* C; int ldc; const rss_t* rss; const rss_t* rss_q = nullptr; const float* stepw = nullptr;
    __device__ __forceinline__ void operator()(const accT& acc, const Unit& u, int wr, int wc, int fr, int fq) const {
        const int row0 = u.pm * 256 + wr * 64 + fr, col0 = u.pn * 256 + wc * 32 + 4 * fq;
#pragma unroll
        for (int ai = 0; ai < 2; ++ai)
#pragma unroll
            for (int m = 0; m < 4; ++m) { const int r = row0 + ai * HALF + m * 16; const float rs = rowf<ACCI>(rss, rss_q, r) * (ACCI ? *stepw : 1.0f); float* rowp = C + (size_t)r * ldc + col0;
#pragma unroll
                for (int bj = 0; bj < 2; ++bj)
#pragma unroll
                    for (int n = 0; n < 2; ++n) *(pg8::f32x4*)(rowp + bj * HALF + n * 16) = acc_f<ACCI>(acc[ai][bj][m][n]) * rs; }
    }
};
typedef EpiRowScaleF32T<false> EpiRowScaleF32; typedef EpiRowScaleF32T<true> EpiRowScaleF32I;
struct EpiProjI {
    static constexpr bool PERM = false; static constexpr int BMAP = 0;
    float* C; int ldc; const rss_t* rss; const rss_t* rss_q; const float* stepw; unsigned char* CQN; rss_t* rsq_out;
    __device__ __forceinline__ void operator()(const accT& acc, const Unit& u, int wr, int wc, int fr, int fq) const {
        const int row0 = u.pm * 256 + wr * 64 + fr, col0 = u.pn * 256 + wc * 32 + 4 * fq; const float st = *stepw;
        if (u.pn < 2) {
#pragma unroll
            for (int ai = 0; ai < 2; ++ai) {
                float rsv[4]; rss_t ra[4], rb[4];
#pragma unroll
                for (int m = 0; m < 4; ++m) { const int r = row0 + ai * HALF + m * 16; ra[m] = rss[r]; rb[m] = rss_q[r]; }
                __builtin_amdgcn_sched_barrier(0);
#pragma unroll
                for (int m = 0; m < 4; ++m) rsv[m] = rstd_raw(ra[m]) * sqrtf(ms_raw(rb[m])) * (st * CQSC / QC);
#pragma unroll
                for (int m = 0; m < 4; ++m) { const int r = row0 + ai * HALF + m * 16; const float rs = rsv[m]; unsigned char* rowp = CQN + (size_t)r * QLORA + col0; float ss = 0.f;
#pragma unroll
                    for (int bj = 0; bj < 2; ++bj)
#pragma unroll
                        for (int n = 0; n < 2; ++n) { const pg8::f32x4 v = acc_f<true>(acc[ai][bj][m][n]) * rs; float t[4];
#pragma unroll
                            for (int e = 0; e < 4; ++e) { const float x = v[e]; t[e] = fminf(fmaxf(__builtin_rintf(x), -128.0f), 127.0f); ss += t[e] * t[e]; }
                            *(unsigned*)(rowp + bj * HALF + n * 16) = pk4_i8(t[0], t[1], t[2], t[3]); }
                    ss += __shfl_xor(ss, 16); ss += __shfl_xor(ss, 32);
                    if (fq == 0) atomicAdd(rsq_out + r, (rss_t)(ss * (RSS_SCALE / (CQSC * CQSC)))); }
                asm volatile("" ::: "memory"); }
        } else {
#pragma unroll
            for (int ai = 0; ai < 2; ++ai) {
                float rsv[4]; rss_t ra[4], rb[4];
#pragma unroll
                for (int m = 0; m < 4; ++m) { const int r = row0 + ai * HALF + m * 16; ra[m] = rss[r]; rb[m] = rss_q[r]; }
                __builtin_amdgcn_sched_barrier(0);
#pragma unroll
                for (int m = 0; m < 4; ++m) rsv[m] = rstd_raw(ra[m]) * sqrtf(ms_raw(rb[m])) * (st / QC);
#pragma unroll
                for (int m = 0; m < 4; ++m) { const int r = row0 + ai * HALF + m * 16; const float rs = rsv[m]; float* rowp = C + (size_t)r * ldc + col0;
#pragma unroll
                    for (int bj = 0; bj < 2; ++bj)
#pragma unroll
                        for (int n = 0; n < 2; ++n) *(pg8::f32x4*)(rowp + bj * HALF + n * 16) = acc_f<true>(acc[ai][bj][m][n]) * rs; }
                asm volatile("" ::: "memory"); }
        }
    }
};
template <bool ACCI> struct EpiZT {
    static constexpr bool PERM = true; static constexpr int BMAP = 1;
    bf16* Z;
    __device__ __forceinline__ void operator()(const accT& acc, const Unit& u, int wr, int wc, int fr, int fq) const {
        const int row0 = u.pm * 256 + wr * 64 + fr, col0 = u.pn * 128 + wc * 32 + 8 * fq;
#pragma unroll
        for (int ai = 0; ai < 2; ++ai)
#pragma unroll
            for (int m = 0; m < 4; ++m) { const int r = row0 + ai * HALF + m * 16;
                const pg8::f32x4 v0 = acc_f<ACCI>(acc[ai][0][m][0]) * acc_f<ACCI>(acc[ai][1][m][0]), v1 = acc_f<ACCI>(acc[ai][0][m][1]) * acc_f<ACCI>(acc[ai][1][m][1]);
                pg8::u32x4 w; w.x = cvt_pk_bf16(v0[0], v0[1]); w.y = cvt_pk_bf16(v0[2], v0[3]); w.z = cvt_pk_bf16(v1[0], v1[1]); w.w = cvt_pk_bf16(v1[2], v1[3]);
                *(pg8::u32x4*)(Z + (size_t)r * DM + col0) = w; }
    }
};
typedef EpiZT<false> EpiZ; typedef EpiZT<true> EpiZI;
template <bool ACCI> struct EpiUT {
    static constexpr bool PERM = true; static constexpr int BMAP = 1;
    bf16* U; const bf16* Z; const float* cw; const float* rfp; const float* step_a = nullptr; const float* step_b = nullptr;
    __device__ __forceinline__ void operator()(const accT& acc, const Unit& u, int wr, int wc, int fr, int fq) const {
        const int row0 = u.pm * 256 + wr * 64 + fr; const float sa = ACCI ? *step_a : 1.0f, sbb = ACCI ? *step_b : 1.0f;
#pragma unroll
        for (int bj = 0; bj < 2; ++bj) { const int col0 = u.pn * 256 + bj * HALF + wc * 32 + 8 * fq;
            float w0[8], w1[8], w2[8];
#pragma unroll
            for (int e = 0; e < 8; ++e) { w0[e] = cw[col0 + e]; w1[e] = cw[DM + col0 + e]; w2[e] = cw[2 * DM + col0 + e]; }
#pragma unroll
            for (int ai = 0; ai < 2; ++ai)
#pragma unroll
                for (int m = 0; m < 4; ++m) { const int r = row0 + ai * HALF + m * 16, t = r & (SEQ - 1);
                    const int r1 = (t >= 1) ? r - 1 : r, r2 = (t >= 2) ? r - 2 : r;
                    const float f0 = rfp[r], f1 = rfp[r1], f2 = rfp[r2];
                    const v4u z2 = *(const v4u*)(Z + (size_t)r * DM + col0), z1 = *(const v4u*)(Z + (size_t)r1 * DM + col0), z0 = *(const v4u*)(Z + (size_t)r2 * DM + col0);
                    __builtin_amdgcn_sched_barrier(0);
                    const float rs = f0 * sbb, ra = f0 * sa, qa = (t >= 1) ? f1 * sa : 0.f, qb = (t >= 2) ? f2 * sa : 0.f;
                    const float s2 = ra * ra, s1 = qa * qa, s0 = qb * qb;
                    float o[8];
#pragma unroll
                    for (int e2 = 0; e2 < 4; ++e2) {
                        const float c0 = w0[2 * e2] * s0 * bflo(z0[e2]) + w1[2 * e2] * s1 * bflo(z1[e2]) + w2[2 * e2] * s2 * bflo(z2[e2]);
                        const float c1 = w0[2 * e2 + 1] * s0 * bfhi(z0[e2]) + w1[2 * e2 + 1] * s1 * bfhi(z1[e2]) + w2[2 * e2 + 1] * s2 * bfhi(z2[e2]);
                        const pg8::f32x4 g0 = acc_f<ACCI>(acc[ai][bj][m][0]), g1 = acc_f<ACCI>(acc[ai][bj][m][1]);
                        const float b0 = (e2 < 2 ? g0[2 * e2] : g1[2 * e2 - 4]) * rs;
                        const float b1 = (e2 < 2 ? g0[2 * e2 + 1] : g1[2 * e2 - 3]) * rs;
                        o[2 * e2] = b0 * c0; o[2 * e2 + 1] = b1 * c1; }
                    pg8::u32x4 w; w.x = cvt_pk_bf16(o[0], o[1]); w.y = cvt_pk_bf16(o[2], o[3]); w.z = cvt_pk_bf16(o[4], o[5]); w.w = cvt_pk_bf16(o[6], o[7]);
                    *(pg8::u32x4*)(U + (size_t)r * DM + col0) = w; } }
    }
};
typedef EpiUT<false> EpiU; typedef EpiUT<true> EpiUI;
template <bool X8OUT, bool ACCI = false> struct EpiResT {
    static constexpr bool PERM = true; static constexpr int BMAP = 1;
    bf16* HB; rss_t* rss_out; const rss_t* rs2_in; float cscale; unsigned char* X8 = nullptr; const rss_t* rss_q = nullptr; const rss_t* rq_in = nullptr; const int* colsum = nullptr; const float* stepw = nullptr;
    __device__ __forceinline__ void operator()(const accT& acc, const Unit& u, int wr, int wc, int fr, int fq) const {
        const int row0 = u.pm * 256 + wr * 64 + fr, col0 = u.pn * 256 + wc * 32 + 8 * fq;
        float ssv[2][4];
        int zc[2][8]; float ics = 0.f;
        if constexpr (ACCI) { ics = *stepw * (HCLIP / 255.0f);
#pragma unroll
            for (int bj = 0; bj < 2; ++bj) { const pg8::u32x4 c0 = *(const pg8::u32x4*)(colsum + col0 + bj * HALF), c1 = *(const pg8::u32x4*)(colsum + col0 + bj * HALF + 4);
#pragma unroll
                for (int e = 0; e < 4; ++e) { zc[bj][e] = (int)c0[e] * 128; zc[bj][4 + e] = (int)c1[e] * 128; } } }

#pragma unroll
        for (int ai = 0; ai < 2; ++ai) {
            pg8::u32x4 hw[4][2]; float sc2[4], qs[4];
#pragma unroll
            for (int m = 0; m < 4; ++m)
#pragma unroll
                for (int bj = 0; bj < 2; ++bj) hw[m][bj] = *(const pg8::u32x4*)(HB + (size_t)(row0 + ai * HALF + m * 16) * DM + col0 + bj * HALF);
            rss_t qraw[4];
#pragma unroll
            for (int m = 0; m < 4; ++m) { sc2[m] = cscale; qs[m] = 0.f; if constexpr (X8OUT) qraw[m] = rss_q[row0 + ai * HALF + m * 16]; }
            if constexpr (X8OUT) { __builtin_amdgcn_sched_barrier(0);
#pragma unroll
                for (int m = 0; m < 4; ++m) qs[m] = QC * rstd_raw(qraw[m]); }
#pragma unroll
            for (int m = 0; m < 4; ++m) { const int r = row0 + ai * HALF + m * 16; const size_t off = (size_t)r * DM + col0; float ss = 0.f;
#pragma unroll
                for (int bj = 0; bj < 2; ++bj) { float hv[8]; const pg8::u32x4 w0 = hw[m][bj];
#pragma unroll
                    for (int e = 0; e < 4; ++e) { hv[2 * e] = bflo(w0[e]); hv[2 * e + 1] = bfhi(w0[e]); }
#pragma unroll
                    for (int e = 0; e < 4; ++e) {
                        if constexpr (ACCI) { const pg8::f32x4 a0 = acc[ai][bj][m][0], a1 = acc[ai][bj][m][1]; const float x0 = a0[e], x1 = a1[e];
                            hv[e] += (float)(__float_as_int(x0) + zc[bj][e]) * ics; hv[4 + e] += (float)(__float_as_int(x1) + zc[bj][4 + e]) * ics; }
                        else { hv[e] += acc[ai][bj][m][0][e] * sc2[m]; hv[4 + e] += acc[ai][bj][m][1][e] * sc2[m]; } }
                    pg8::u32x4 w; w.x = cvt_pk_bf16(hv[0], hv[1]); w.y = cvt_pk_bf16(hv[2], hv[3]); w.z = cvt_pk_bf16(hv[4], hv[5]); w.w = cvt_pk_bf16(hv[6], hv[7]);
                    *(pg8::u32x4*)(HB + off + bj * HALF) = w;
                    if constexpr (X8OUT) *(v2u*)(X8 + off + bj * HALF) = (v2u){pk4_i8(hv[0] * qs[m], hv[1] * qs[m], hv[2] * qs[m], hv[3] * qs[m]), pk4_i8(hv[4] * qs[m], hv[5] * qs[m], hv[6] * qs[m], hv[7] * qs[m])};
#pragma unroll
                    for (int e = 0; e < 4; ++e) { const float a = bflo(w[e]), b = bfhi(w[e]); ss += a * a + b * b; } }
                ssv[ai][m] = ss; }
            asm volatile("" ::: "memory");
        }
#pragma unroll
        for (int ai = 0; ai < 2; ++ai)
#pragma unroll
            for (int m = 0; m < 4; ++m) { float ss = ssv[ai][m]; ss += __shfl_xor(ss, 16); ss += __shfl_xor(ss, 32);
                if (fq == 0) atomicAdd(rss_out + row0 + ai * HALF + m * 16, (rss_t)(ss * RSS_SCALE)); }
    }
};

typedef EpiResT<false> EpiRes; typedef EpiResT<true> EpiResX8; typedef EpiResT<true, true> EpiResI; typedef EpiResT<false, true> EpiResIL;

__device__ __forceinline__ float wave_sum(float v) {
#pragma unroll
    for (int o = 1; o < 64; o <<= 1) v += __shfl_xor(v, o);
    return v;
}
__device__ __forceinline__ float wave_max(float v) {
#pragma unroll
    for (int o = 1; o < 64; o <<= 1) v = fmaxf(v, __shfl_xor(v, o));
    return v;
}
__device__ __forceinline__ void conv_item(const float* __restrict__ W, int ldw, int c0, int cvalid, const float* __restrict__ g, float gs, bf16* __restrict__ WT, int ldt, int drow0, int dcol0, int nblk, int item, int lane) {
    const int kb = item / nblk, nb = item % nblk, c = lane & 7, n4 = lane >> 3, k0 = 128 * kb + 8 * c, cs = c0 + 32 * nb + 4 * n4;
    f32x4 v[2][8];
#pragma unroll
    for (int hh = 0; hh < 2; ++hh)
#pragma unroll
        for (int i = 0; i < 8; ++i) { v[hh][i] = (f32x4){0.f, 0.f, 0.f, 0.f}; if (cs < cvalid) v[hh][i] = *(const f32x4*)(W + (size_t)(k0 + 64 * hh + i) * ldw + cs); }
#pragma unroll
    for (int hh = 0; hh < 2; ++hh) {
        if (g) {
            const f32x4 g0 = *(const f32x4*)(g + k0 + 64 * hh), g1 = *(const f32x4*)(g + k0 + 64 * hh + 4);
#pragma unroll
            for (int i = 0; i < 4; ++i) { v[hh][i] = v[hh][i] * (g0[i] * gs); v[hh][4 + i] = v[hh][4 + i] * (g1[i] * gs); }
        }
#pragma unroll
        for (int e = 0; e < 4; ++e) {
            v4u o; o.x = pk2(v[hh][0][e], v[hh][1][e]); o.y = pk2(v[hh][2][e], v[hh][3][e]); o.z = pk2(v[hh][4][e], v[hh][5][e]); o.w = pk2(v[hh][6][e], v[hh][7][e]);
            *(v4u*)(WT + (size_t)(drow0 + 32 * nb + 4 * n4 + e) * ldt + dcol0 + k0 + 64 * hh) = o; }
    }
}

__device__ __forceinline__ void conv_item_f8(const float* __restrict__ W, int ldw, const float* __restrict__ g, unsigned char* __restrict__ WT, int ldt, float scale, int nblk, int item, int lane) {
    const int kb = item / nblk, nb = item % nblk, c = lane & 7, n4 = lane >> 3, k0 = 128 * kb + 16 * c, cs = 32 * nb + 4 * n4;
    f32x4 v[16];
#pragma unroll
    for (int i = 0; i < 16; ++i) v[i] = *(const f32x4*)(W + (size_t)(k0 + i) * ldw + cs) * (g ? g[k0 + i] * scale : scale);
#pragma unroll
    for (int e = 0; e < 4; ++e) {
        v4u o; o.x = pk4_fp8(v[0][e], v[1][e], v[2][e], v[3][e]); o.y = pk4_fp8(v[4][e], v[5][e], v[6][e], v[7][e]); o.z = pk4_fp8(v[8][e], v[9][e], v[10][e], v[11][e]); o.w = pk4_fp8(v[12][e], v[13][e], v[14][e], v[15][e]);
        *(v4u*)(WT + (size_t)(32 * nb + 4 * n4 + e) * ldt + k0) = o; }
}

__device__ __forceinline__ float sample_step(const float* __restrict__ Ws, int ldw, const float* __restrict__ g, int lane) {
    const int c = lane & 7, n4 = lane >> 3; float ss = 0.f;
#pragma unroll
    for (int i = 0; i < 16; ++i) { const f32x4 t = *(const f32x4*)(Ws + (size_t)(16 * c + i) * ldw + 4 * n4) * (g ? g[16 * c + i] : 1.0f); ss += (t[0] * t[0] + t[1] * t[1]) + (t[2] * t[2] + t[3] * t[3]); }
    ss = wave_sum(ss);
    return WCLIP * sqrtf(ss * (1.0f / 4096.0f)) * (1.0f / 127.0f);
}
__device__ __forceinline__ void conv_item_i8(const float* __restrict__ W, int ldw, const float* __restrict__ g, unsigned char* __restrict__ WT, int ldt, float step, int nblk, int item, int lane, int* __restrict__ colsum = nullptr,
                                             int c0 = 0, int cvalid = 1 << 30, int drow0 = 0) {
    const int kb = item / nblk, nb = item % nblk, c = lane & 7, n4 = lane >> 3, k0 = 128 * kb + 16 * c, cs = c0 + 32 * nb + 4 * n4;
    f32x4 v[16];
#pragma unroll
    for (int i = 0; i < 16; ++i) { v[i] = (f32x4){0.f, 0.f, 0.f, 0.f}; if (cs < cvalid) v[i] = *(const f32x4*)(W + (size_t)(k0 + i) * ldw + cs) * (g ? g[k0 + i] : 1.0f); }
    const float inv = 1.0f / step;
#pragma unroll
    for (int e = 0; e < 4; ++e) {
        v4u o; o.x = pk4_i8(v[0][e] * inv, v[1][e] * inv, v[2][e] * inv, v[3][e] * inv); o.y = pk4_i8(v[4][e] * inv, v[5][e] * inv, v[6][e] * inv, v[7][e] * inv);
        o.z = pk4_i8(v[8][e] * inv, v[9][e] * inv, v[10][e] * inv, v[11][e] * inv); o.w = pk4_i8(v[12][e] * inv, v[13][e] * inv, v[14][e] * inv, v[15][e] * inv);
        *(v4u*)(WT + (size_t)(drow0 + 32 * nb + 4 * n4 + e) * ldt + k0) = o;
        if (colsum) {
            float cs4 = 0.f;
#pragma unroll
            for (int i = 0; i < 16; ++i) cs4 += fminf(fmaxf(__builtin_rintf(v[i][e] * inv), -128.0f), 127.0f);
            cs4 += __shfl_xor(cs4, 1); cs4 += __shfl_xor(cs4, 2); cs4 += __shfl_xor(cs4, 4);
            if (c == 0) atomicAdd(colsum + 32 * nb + 4 * n4 + e, (int)cs4); } }
}

__device__ __forceinline__ int wave_sum_i32(int v) {
    v += __builtin_amdgcn_update_dpp(0, v, 0xB1, 0xF, 0xF, false);
    v += __builtin_amdgcn_update_dpp(0, v, 0x4E, 0xF, 0xF, false);
    v += __builtin_amdgcn_update_dpp(0, v, 0x141, 0xF, 0xF, false);
    v += __builtin_amdgcn_update_dpp(0, v, 0x140, 0xF, 0xF, false);
    return __builtin_amdgcn_readlane(v, 0) + __builtin_amdgcn_readlane(v, 16) + __builtin_amdgcn_readlane(v, 32) + __builtin_amdgcn_readlane(v, 48);
}
template <int NCH> __device__ __forceinline__ void wave_topk256(const LAS float* sc, bf16* out, int lane) {
    constexpr int NK = 4 * NCH;
    unsigned key[NK];
#pragma unroll
    for (int r = 0; r < NCH; ++r) {
        f32x4 v = (f32x4){0.f, 0.f, 0.f, 0.f}; const bool have = true;
        v = *(const LAS f32x4*)(sc + 256 * r + 4 * lane);
#pragma unroll
        for (int e = 0; e < 4; ++e) { const float fe = v[e]; const unsigned uu = __float_as_uint(fe);
            const unsigned k = (uu & 0x80000000u) ? ~uu : (uu | 0x80000000u); key[4 * r + e] = have ? k : 0u; }
    }
    unsigned T = 0u; bool exact = false;
#pragma unroll 1
    for (int bit = 31; bit >= 0; --bit) {
        const unsigned cand = T | (1u << bit); int c = 0;
#pragma unroll
        for (int i = 0; i < NK; ++i) c += (key[i] >= cand) ? 1 : 0;
        const int cnt = wave_sum_i32(c);
        if (cnt >= TOPK) { T = cand; if (cnt == TOPK) { exact = true; break; } }
    }
    int need = 0;
    if (exact) T -= 1u;
    else { int c = 0;
#pragma unroll
        for (int i = 0; i < NK; ++i) c += (key[i] > T) ? 1 : 0;
        need = TOPK - wave_sum_i32(c); }
    int pos = 0;
    if (need == 0) {
#pragma unroll
        for (int i = 0; i < NK; ++i) {
            const bool sel = key[i] > T; const unsigned long long ms = __ballot(sel);
            const int p = pos + (int)__builtin_amdgcn_mbcnt_hi((unsigned)(ms >> 32), __builtin_amdgcn_mbcnt_lo((unsigned)ms, 0u));
            if (sel && p < TOPK) out[p] = (bf16)(256 * (i >> 2) + 4 * lane + (i & 3));
            pos += __popcll(ms);
        }
    } else {
        int tk = 0;
#pragma unroll
        for (int i = 0; i < NK; ++i) {
            const bool gt = key[i] > T, eq = key[i] == T;
            const unsigned long long meq = __ballot(eq);
            const int eqrank = tk + (int)__builtin_amdgcn_mbcnt_hi((unsigned)(meq >> 32), __builtin_amdgcn_mbcnt_lo((unsigned)meq, 0u));
            const bool sel = gt || (eq && eqrank < need);
            const unsigned long long ms = __ballot(sel);
            const int p = pos + (int)__builtin_amdgcn_mbcnt_hi((unsigned)(ms >> 32), __builtin_amdgcn_mbcnt_lo((unsigned)ms, 0u));
            if (sel && p < TOPK) out[p] = (bf16)(256 * (i >> 2) + 4 * lane + (i & 3));
            pos += __popcll(ms); tk += __popcll(meq);
        }
    }
}

typedef short bf16x8_t __attribute__((ext_vector_type(8)));
typedef short s16x4_t __attribute__((ext_vector_type(4)));
typedef float f4_t __attribute__((ext_vector_type(4)));
__device__ __forceinline__ s16x4_t lds_tr16(unsigned addr) {
    typedef short v4i16_t __attribute__((ext_vector_type(4)));
    return __builtin_bit_cast(s16x4_t, __builtin_amdgcn_ds_read_tr16_b64_v4i16((LAS v4i16_t*)(uintptr_t)addr));
}
constexpr int KST = 528;
constexpr int ATT_WAVE_LDS = 32 * KST + 512;

__device__ __forceinline__ void attn_query(const bf16* __restrict__ CKVb, const bf16* IDXrow, bf16* QO  , int nsel, LAS unsigned char* wl, int lane) {
    const int j = lane & 15, g = lane >> 4;
    LAS bf16* ids = (LAS bf16*)(wl + 32 * KST);
    *(LAS v2u*)(ids + 4 * lane) = *(const v2u*)(IDXrow + 4 * lane);
    bf16x8_t Bq[8];
#pragma unroll
    for (int s = 0; s < 8; ++s) Bq[s] = *(const bf16x8_t*)(QO + j * 256 + 32 * s + 8 * g);
    f4_t O[16];
#pragma unroll
    for (int d = 0; d < 16; ++d) O[d] = (f4_t){0.f, 0.f, 0.f, 0.f};
    float mrun = -__builtin_inff(), lsum = 0.f;
    const int nch = (nsel + 31) >> 5;
    asm volatile("s_waitcnt lgkmcnt(0)" ::: "memory");
    const unsigned wl_addr = (unsigned)(uintptr_t)wl;
    const unsigned a_rd = wl_addr + j * KST + 16 * g;
    const unsigned a_tr = wl_addr + (4 * g + (j >> 2)) * KST + 8 * (j & 3);
    v4u v[16];
#pragma unroll
    for (int p = 0; p < 16; ++p) { const int key = (int)ids[2 * p + (lane >> 5)];
        v[p] = *(const v4u*)(CKVb + (size_t)key * KVL + (lane & 31) * 8); }
    for (int c = 0; c < nch; ++c) {
#pragma unroll
        for (int p = 0; p < 16; ++p) *(LAS v4u*)(wl + (2 * p + (lane >> 5)) * KST + (lane & 31) * 16) = v[p];
        if (c + 1 < nch) {
#pragma unroll
            for (int p = 0; p < 16; ++p) { const int key = (int)ids[32 * (c + 1) + 2 * p + (lane >> 5)];
                v[p] = *(const v4u*)(CKVb + (size_t)key * KVL + (lane & 31) * 8); }
        }
        asm volatile("s_waitcnt lgkmcnt(0)" ::: "memory");
        f4_t S0 = (f4_t){0.f, 0.f, 0.f, 0.f}, S1 = (f4_t){0.f, 0.f, 0.f, 0.f};
#pragma unroll
        for (int s0 = 0; s0 < 8; s0 += ATT_RB) {
            bf16x8_t A0[ATT_RB], A1[ATT_RB];
#pragma unroll
            for (int q = 0; q < ATT_RB; ++q) { A0[q] = *(const LAS bf16x8_t*)(uintptr_t)(a_rd + 64 * (s0 + q)); A1[q] = *(const LAS bf16x8_t*)(uintptr_t)(a_rd + 16 * KST + 64 * (s0 + q)); }
            __builtin_amdgcn_sched_barrier(0);
#pragma unroll
            for (int q = 0; q < ATT_RB; ++q) { S0 = __builtin_amdgcn_mfma_f32_16x16x32_bf16(A0[q], Bq[s0 + q], S0, 0, 0, 0); S1 = __builtin_amdgcn_mfma_f32_16x16x32_bf16(A1[q], Bq[s0 + q], S1, 0, 0, 0); }
            __builtin_amdgcn_sched_barrier(0);
        }
        if (c == nch - 1) { const int kb = 32 * c + 4 * g;
#pragma unroll
            for (int i = 0; i < 4; ++i) { if (kb + i >= nsel) S0[i] = -__builtin_inff(); if (kb + 16 + i >= nsel) S1[i] = -__builtin_inff(); } }
        float mx = fmaxf(fmaxf(fmaxf(S0[0], S0[1]), fmaxf(S0[2], S0[3])), fmaxf(fmaxf(S1[0], S1[1]), fmaxf(S1[2], S1[3])));
        mx = fmaxf(mx, __shfl_xor(mx, 16)); mx = fmaxf(mx, __shfl_xor(mx, 32));
        const float mnew = fmaxf(mrun, mx), mrun0 = mrun;
        const float alpha = exp2f(mrun - mnew);
        float ps = 0.f; float p0[4], p1[4];
#pragma unroll
        for (int i = 0; i < 4; ++i) { p0[i] = exp2f(S0[i] - mnew); p1[i] = exp2f(S1[i] - mnew); ps += p0[i] + p1[i]; }
        lsum = lsum * alpha + ps; mrun = mnew;
        if (__any(mnew > mrun0)) {
#pragma unroll
            for (int d = 0; d < 16; ++d) O[d] = O[d] * alpha; }
        bf16x8_t Bp; { const unsigned w0 = pg8::cvt_pk_bf16(p0[0], p0[1]), w1 = pg8::cvt_pk_bf16(p0[2], p0[3]), w2 = pg8::cvt_pk_bf16(p1[0], p1[1]), w3 = pg8::cvt_pk_bf16(p1[2], p1[3]);
            Bp = __builtin_bit_cast(bf16x8_t, (v4u){w0, w1, w2, w3}); }
#pragma unroll
        for (int d0 = 0; d0 < 16; d0 += ATT_PB) {
            s16x4_t lo[ATT_PB], hi[ATT_PB];
#pragma unroll
            for (int q = 0; q < ATT_PB; ++q) { lo[q] = lds_tr16(a_tr + 32 * (d0 + q)); hi[q] = lds_tr16(a_tr + 16 * KST + 32 * (d0 + q)); }
            __builtin_amdgcn_sched_barrier(0);
#pragma unroll
            for (int q = 0; q < ATT_PB; ++q) { const bf16x8_t A = (bf16x8_t){lo[q][0], lo[q][1], lo[q][2], lo[q][3], hi[q][0], hi[q][1], hi[q][2], hi[q][3]};
                O[d0 + q] = __builtin_amdgcn_mfma_f32_16x16x32_bf16(A, Bp, O[d0 + q], 0, 0, 0); }
            __builtin_amdgcn_sched_barrier(0);
        }
        asm volatile("s_waitcnt lgkmcnt(0)" ::: "memory");
    }
    lsum += __shfl_xor(lsum, 16); lsum += __shfl_xor(lsum, 32);
    const float inv = 1.0f / lsum;
#pragma unroll
    for (int d = 0; d < 16; ++d) { const f4_t o = O[d] * inv; *(v2u*)(QO + j * 256 + 16 * d + 4 * g) = (v2u){pg8::cvt_pk_bf16(o[0], o[1]), pg8::cvt_pk_bf16(o[2], o[3])}; }
}

constexpr int SCST = 2192;
static_assert(2 * SCST * 4 >= ATT_WAVE_LDS && 16 * SCST * 4 + 1024 <= LDS_PHASE_BYTES, "indexer / attention LDS map");
__device__ __forceinline__ void index_unit(const bf16* __restrict__ QIDX, const bf16* __restrict__ KIDXb, const float* __restrict__ WIDX, bf16* IDX, const bf16* __restrict__ CKVb, bf16* QLAT, int b, int qt, LAS unsigned char* lds, int wave_s) {
    const int tid = fresh_tid(wave_s);
    const int lane = tid & 63, wave = __builtin_amdgcn_readfirstlane(tid >> 6);
    const int row0 = b * SEQ + 16 * qt;
    if (qt < 16) {
        const int e8 = tid * 8, k = e8 & 255;
        const unsigned k0 = (unsigned)k | ((unsigned)(k + 1) << 16), k1 = (unsigned)(k + 2) | ((unsigned)(k + 3) << 16), k2 = (unsigned)(k + 4) | ((unsigned)(k + 5) << 16), k3 = (unsigned)(k + 6) | ((unsigned)(k + 7) << 16);
        *(v4u*)(IDX + (size_t)row0 * TOPK + e8) = (v4u){k0, k1, k2, k3};
        __syncthreads();
#pragma unroll 1
        for (int qq = 0; qq < 2; ++qq) { const int row = row0 + 2 * wave + qq, t = row & (SEQ - 1);
            attn_query(CKVb, IDX + (size_t)row * TOPK, QLAT + (size_t)row * 4096, (t + 1 < TOPK) ? t + 1 : TOPK, lds + wave * (2 * SCST * 4), lane); }
        __syncthreads();
        return;
    }
    LAS float* sc = (LAS float*)lds;
    const int j = lane & 15, g = lane >> 4;
    constexpr int QST = 2048 + 16;
#pragma unroll
    for (int i = 0; i < 4; ++i) { const int pc = tid + NTHR * i, rw = pc >> 7, c16 = pc & 127;
        *(LAS v4u*)(lds + rw * QST + c16 * 16) = *(const v4u*)(QIDX + (size_t)(row0 + rw) * 1024 + c16 * 8); }
    LAS float* wl = (LAS float*)(lds + 16 * SCST * 4);
    if (tid < 256) wl[tid] = WIDX[(size_t)row0 * IDXH + tid];
    __syncthreads();
    bf16x8_t Bq[16][2];
#pragma unroll
    for (int h = 0; h < 16; ++h)
#pragma unroll
        for (int s2 = 0; s2 < 2; ++s2) Bq[h][s2] = *(const LAS bf16x8_t*)(lds + j * QST + h * 128 + s2 * 64 + g * 16);
    __syncthreads();
    const LAS float* wq = wl + j * IDXH;
    const int nT = qt + 1, nTpad = ((nT + 15) >> 4) << 4;
    const float ninf = -__builtin_inff();
    const bf16x8_t zf = (bf16x8_t){0, 0, 0, 0, 0, 0, 0, 0};
    bf16x8_t Pa0 = zf, Pa1 = zf, Pb0 = zf, Pb1 = zf, Pc0 = zf, Pc1 = zf;
    { const bf16* kp = KIDXb + (size_t)j * IDXD + 8 * g;
      if (wave < nT) { Pa0 = *(const bf16x8_t*)(kp + (size_t)(16 * wave) * IDXD); Pa1 = *(const bf16x8_t*)(kp + (size_t)(16 * wave) * IDXD + 32); }
      if (wave + NWAVES < nT) { Pb0 = *(const bf16x8_t*)(kp + (size_t)(16 * (wave + NWAVES)) * IDXD); Pb1 = *(const bf16x8_t*)(kp + (size_t)(16 * (wave + NWAVES)) * IDXD + 32); }
      if (wave + 2 * NWAVES < nT) { Pc0 = *(const bf16x8_t*)(kp + (size_t)(16 * (wave + 2 * NWAVES)) * IDXD); Pc1 = *(const bf16x8_t*)(kp + (size_t)(16 * (wave + 2 * NWAVES)) * IDXD + 32); } }
    for (int T = wave; T < nTpad; T += NWAVES) {
        f4_t score = (f4_t){ninf, ninf, ninf, ninf};
        const bf16x8_t A0 = Pa0, A1 = Pa1;
        Pa0 = Pb0; Pa1 = Pb1; Pb0 = Pc0; Pb1 = Pc1;
        if (T + 3 * NWAVES < nT) { const bf16* kp = KIDXb + (size_t)(16 * (T + 3 * NWAVES) + j) * IDXD + 8 * g; Pc0 = *(const bf16x8_t*)kp; Pc1 = *(const bf16x8_t*)(kp + 32); }
        if (T < nT) {
            score = (f4_t){0.f, 0.f, 0.f, 0.f};
#pragma unroll
            for (int h = 0; h < 16; ++h) {
                f4_t D = __builtin_amdgcn_mfma_f32_16x16x32_bf16(A0, Bq[h][0], (f4_t){0.f, 0.f, 0.f, 0.f}, 0, 0, 0);
                D = __builtin_amdgcn_mfma_f32_16x16x32_bf16(A1, Bq[h][1], D, 0, 0, 0);
                { const float wh = wq[h];
#pragma unroll
                for (int i = 0; i < 4; ++i) score[i] += wh * __builtin_amdgcn_fmed3f(D[i], 0.f, __builtin_inff()); }
                if ((h & 3) == 3) __builtin_amdgcn_sched_barrier(0);
            }
            if (T == qt) {
#pragma unroll
                for (int i = 0; i < 4; ++i) if (4 * g + i > j) score[i] = ninf;
            }
        }
        *(LAS f4_t*)(sc + j * SCST + 16 * T + 4 * g) = score;
    }
    __syncthreads();
#pragma unroll 1
    for (int qq = 0; qq < 2; ++qq) { const int q = 2 * wave + qq; const LAS float* sq = sc + q * SCST; bf16* oq = IDX + (size_t)(row0 + q) * TOPK;
        switch (qt >> 4) {
            case 1: wave_topk256<2>(sq, oq, lane); break; case 2: wave_topk256<3>(sq, oq, lane); break; case 3: wave_topk256<4>(sq, oq, lane); break;
            case 4: wave_topk256<5>(sq, oq, lane); break; case 5: wave_topk256<6>(sq, oq, lane); break; case 6: wave_topk256<7>(sq, oq, lane); break;
            default: wave_topk256<8>(sq, oq, lane); break; } }
    asm volatile("s_waitcnt vmcnt(0)" ::: "memory");
#pragma unroll 1
    for (int qq = 0; qq < 2; ++qq) { const int row = row0 + 2 * wave + qq;
        attn_query(CKVb, IDX + (size_t)row * TOPK, QLAT + (size_t)row * 4096, TOPK, lds + wave * (2 * SCST * 4), lane); }
    __syncthreads();
}

struct Args { const float* in[19]; float* out; unsigned char* ws; int ph_lo, ph_hi; };
constexpr int PH_PRO = 0, PH_PER_PAIR = 15, PH_FINAL = 1 + 2 * PH_PER_PAIR, N_PHASES = PH_FINAL + 1;

__global__ void __launch_bounds__(NTHR, 2) fwd(Args args) {
    extern __shared__ __attribute__((aligned(16))) unsigned char lds_raw[];
    LAS unsigned char* lds = (LAS unsigned char*)lds_raw;
    const int tid0 = threadIdx.x; const int wave_s = __builtin_amdgcn_readfirstlane(tid0 >> 6);
#define PHASE_IDS const int tid = fresh_tid(wave_s); const int lane = tid & 63, wave = wave_s; const int gw = blockIdx.x * NWAVES + wave, NGW = G * NWAVES; (void)lane; (void)gw; (void)NGW
    const int G = gridDim.x;
    unsigned char* ws = args.ws;
    gu32* ctl = (gu32*)(ws + WS_CTL);
    const int lo = args.ph_lo, hi = args.ph_hi;
    const float* x = args.in[0]; const float* norm_mix = args.in[1]; const float* norm_mlp = args.in[2]; const float* mlp_w1 = args.in[3]; const float* mlp_w2 = args.in[4];
    const float* conv_in = args.in[5]; const float* conv_w = args.in[6]; const float* conv_out = args.in[7]; const float* attn_in = args.in[8];
    const float* q_norm = args.in[9]; const float* kv_norm = args.in[10]; const float* w_uq = args.in[11]; const float* w_uk = args.in[12]; const float* w_uv = args.in[13];
    const float* w_qidx = args.in[14]; const float* ln_g = args.in[15]; const float* ln_b = args.in[16]; const float* attn_out = args.in[17]; const float* final_norm = args.in[18];
    bf16* HB = (bf16*)(ws + WS_HB);
    rss_t* RSS = (rss_t*)(ws + WS_RSS);
    float* SBW = (float*)(ws + WS_SBW);
    float* RFV = (float*)(ws + WS_SBW + 65536);
    int* COLSUM = (int*)(ws + WS_SBW + 4096);

    LAS unsigned* MISC = (LAS unsigned*)(lds + LDSCTL_OFF);
    for (int u = tid0; u < (LDS_BYTES - LDSCTL_OFF) / 4; u += NTHR) MISC[u] = 0u;
    __syncthreads();
    XcdBarrier bar; bar.bar = (unsigned*)(ctl + CW_BAR); bar.x = 0; bar.st = nullptr; bar.wave_s = wave_s;
    if (MK_ONE_LAUNCH) bar = xcd_barrier_post((unsigned*)(ctl + CW_BAR), (volatile LAS unsigned*)(MISC + 8), wave_s);
#define IN(k) (lo <= (k) && (k) < hi)
#define SEAM(k) do { if (IN(k) && IN((k) + 1)) xcd_barrier(bar); } while (0)
#define SEAM_G(k) do { if (IN(k) && IN((k) + 1)) { if (GROUP_SEAMS) { if (MISC[16]) grp_barrier_fast((unsigned*)(ctl + CW_BAR), bar.x, wave_s); else grp_barrier((unsigned*)(ctl + CW_BAR), (int)(blockIdx.x & 7), wave_s); } else xcd_barrier(bar); } } while (0)

    if (IN(PH_PRO)) {
        PHASE_IDS;
        {
        LAS float* stepL = (LAS float*)lds;
        for (int sl = wave; sl < 18; sl += NWAVES) {
            int lane_l = lane; asm volatile("" : "+v"(lane_l)); const int lane = lane_l;
            float st = 0.f; const int j = sl & 1;
            if (sl < 4) st = sample_step(mlp_w1 + (size_t)sl * DM * FF, FF, norm_mlp + (size_t)sl * DM, lane);
            else if (sl < 8) st = sample_step(mlp_w2 + (size_t)(sl - 4) * FF * DM, DM, nullptr, lane);
            else if (sl < 10) { if (j >= I8_CONV_FROM) st = sample_step(conv_in + (size_t)j * DM * 3 * DM + DM, 3 * DM, norm_mix + (size_t)(2 * j) * DM, lane); }
            else if (sl < 12) { if (j >= I8_CONV_FROM) st = sample_step(conv_in + (size_t)j * DM * 3 * DM, 3 * DM, norm_mix + (size_t)(2 * j) * DM, lane); }
            else if (sl < 14) st = sample_step(attn_in + (size_t)j * DM * INC, INC, norm_mix + (size_t)(2 * j + 1) * DM, lane);
            else if (sl < 16) {
                const float* uq0 = w_uq + (size_t)j * QLORA * 2048; const float* uk0 = w_uk + (size_t)j * NHEAD * 128 * KVL + lane; const float* gq0 = q_norm + (size_t)j * QLORA;
                float a0[4] = {0.f, 0.f, 0.f, 0.f};
                for (int d = 0; d < 128; ++d) { const float bv = uk0[(size_t)d * KVL];
#pragma unroll
                    for (int i = 0; i < 4; ++i) a0[i] += uq0[(size_t)i * 2048 + d] * bv; }
                float ss = 0.f;
#pragma unroll
                for (int i = 0; i < 4; ++i) { const float t = a0[i] * gq0[i] * QSCALE; ss += t * t; }
                ss = wave_sum(ss); st = WCLIP * sqrtf(ss * (1.0f / 256.0f)) * (1.0f / 127.0f); }
            else st = sample_step(w_qidx + (size_t)j * QLORA * 1024, 1024, q_norm + (size_t)j * QLORA, lane);
            if (lane == 0) { stepL[sl] = st; if (blockIdx.x == 0) SBW[sl] = st; }
        }
        __syncthreads();
        constexpr int I_CA = (DM / 128) * (4096 / 32), I_CB = (DM / 128) * (DM / 32), I_CO = I_CB;
        constexpr int I_W1 = (DM / 128) * (FF / 32), I_W2 = (FF / 128) * (DM / 32);
        constexpr int I_AI = (DM / 128) * (INCP / 32), I_QI = (QLORA / 128) * (1024 / 32), I_UV = 16 * (KVL / 128) * (128 / 32), I_AO = I_CB;
        constexpr int PER_CONV = I_CA + I_CB + I_CO, PER_MLP = I_W1 + I_W2, PER_ATT = I_AI + I_QI + I_UV + I_AO;
        constexpr int NITEMS = 2 * PER_CONV + 4 * PER_MLP + 2 * PER_ATT;
        for (int it = gw; it < NITEMS; it += NGW) {
            int lane_l = lane; asm volatile("" : "+v"(lane_l)); const int lane = lane_l;
            int r = it;
            if (r < 2 * PER_CONV) { const int j = r / PER_CONV; r -= j * PER_CONV;
                const float* Wi = conv_in + (size_t)j * DM * 3 * DM; const float* gn = norm_mix + (size_t)(2 * j) * DM;
                if (r < I_CA) {
                    const int nb = r % 128, kb = r / 128, pn = nb >> 3, which = (nb >> 2) & 1, i0 = (nb & 3) * 32;
                    if (j >= I8_CONV_FROM) conv_item_i8(Wi, 3 * DM, gn, (unsigned char*)(ws + WS_WCA + j * CONV_W_STRIDE), DM, stepL[8 + j], 1, kb, lane, nullptr, DM * (1 + which) + 128 * pn + i0, 3 * DM, 32 * nb);
                    else conv_item(Wi, 3 * DM, DM * (1 + which) + 128 * pn + i0, 3 * DM, gn, 1.f, (bf16*)(ws + WS_WCA + j * CONV_W_STRIDE), DM, 32 * nb, 0, 1, kb, lane);
                    continue; }
                r -= I_CA;
                if (r < I_CB) {
                    if (j >= I8_CONV_FROM) conv_item_i8(Wi, 3 * DM, gn, (unsigned char*)(ws + WS_WCB + j * CONV_W_STRIDE), DM, stepL[10 + j], DM / 32, r, lane);
                    else conv_item(Wi, 3 * DM, 0, DM, gn, 1.f, (bf16*)(ws + WS_WCB + j * CONV_W_STRIDE), DM, 0, 0, DM / 32, r, lane);
                    continue; }
                r -= I_CB;
                conv_item(conv_out + (size_t)j * DM * DM, DM, 0, DM, nullptr, 1.f, (bf16*)(ws + WS_WCO + j * CONV_W_STRIDE), DM, 0, 0, DM / 32, r, lane); continue; }
            r -= 2 * PER_CONV;
            if (r < 4 * PER_MLP) { const int i = r / PER_MLP; r -= i * PER_MLP;
                if (r < I_W1) {
                    conv_item_i8(mlp_w1 + (size_t)i * DM * FF, FF, norm_mlp + (size_t)i * DM, (unsigned char*)(ws + WS_W1 + i * W1_STRIDE), DM, stepL[i], FF / 32, r, lane);
                    continue; }
                r -= I_W1;
                conv_item_i8(mlp_w2 + (size_t)i * FF * DM, DM, nullptr, (unsigned char*)(ws + WS_W2 + i * W2_STRIDE), FF, stepL[4 + i], DM / 32, r, lane, COLSUM + i * DM);
                continue; }
            r -= 4 * PER_MLP;
            { const int j = r / PER_ATT; r -= j * PER_ATT;
                if (r < I_AI) { conv_item_i8(attn_in + (size_t)j * DM * INC, INC, norm_mix + (size_t)(2 * j + 1) * DM, (unsigned char*)(ws + WS_WAI + j * ATT_W_STRIDE), DM, stepL[12 + j], INCP / 32, r, lane, nullptr, 0, INC); continue; }
                r -= I_AI;
                if (r < I_QI) { conv_item_i8(w_qidx + (size_t)j * QLORA * 1024, 1024, q_norm + (size_t)j * QLORA, (unsigned char*)(ws + WS_WQ + j * ATT_W_STRIDE), QLORA, stepL[16 + j], 1024 / 32, r, lane, nullptr, 0, 1 << 30, 4096); continue; }
                r -= I_QI;
                if (r < I_UV) {
                    const int h = r / 8, rr = r % 8;
                    conv_item(w_uv + (size_t)j * NHEAD * KVL * 128 + (size_t)h * KVL * 128, 128, 0, 128, nullptr, 1.f, (bf16*)(ws + WS_WUV + j * ATT_W_STRIDE), 512, h * 128, (h & 1) * 256, 4, rr, lane); continue; }
                r -= I_UV;
                if (FP8_AO) conv_item_f8(attn_out + (size_t)j * DM * DM, DM, nullptr, (unsigned char*)(ws + WS_WAO + j * ATT_W_STRIDE), DM, 64.0f, DM / 32, r, lane);
                else conv_item(attn_out + (size_t)j * DM * DM, DM, 0, DM, nullptr, 1.f, (bf16*)(ws + WS_WAO + j * ATT_W_STRIDE), DM, 0, 0, DM / 32, r, lane); }
        }
        for (int it = gw; it < 2 * 2048; it += NGW) { const int j = it >> 11, n = it & 2047, h = n >> 7;
            bf16* p = (bf16*)(ws + WS_WUV + j * ATT_W_STRIDE) + (size_t)n * 512 + (1 - (h & 1)) * 256;
            *(v2u*)(p + 4 * lane) = (v2u){0u, 0u}; }
        for (int it = gw; it < 2 * 16 * 32 * 4; it += NGW) {
            const int cb = it & 3, rb = (it >> 2) & 31, h = (it >> 7) & 15, j = it >> 11;
            const float* uq = w_uq + (size_t)j * QLORA * 2048 + (size_t)(rb * 16) * 2048 + h * 128;
            const float* uk = w_uk + (size_t)j * NHEAD * 128 * KVL + (size_t)h * 128 * KVL + cb * 64 + lane;
            float a[16];
#pragma unroll
            for (int i = 0; i < 16; ++i) a[i] = 0.f;
            LAS float* aL = (LAS float*)(lds + 1024 + wave * 8192);
#pragma unroll
            for (int q = 0; q < 8; ++q) { const int f = 4 * (lane + 64 * q); *(LAS f32x4*)(aL + f) = *(const f32x4*)(uq + (size_t)(f >> 7) * 2048 + (f & 127)); }
#pragma unroll 2
            for (int d = 0; d < 128; d += 8) { float bv[8];
#pragma unroll
                for (int t = 0; t < 8; ++t) bv[t] = uk[(size_t)(d + t) * KVL];
#pragma unroll
                for (int i = 0; i < 16; ++i) { const f32x4 a0 = *(const LAS f32x4*)(aL + i * 128 + d), a1 = *(const LAS f32x4*)(aL + i * 128 + d + 4);
                    a[i] += (a0[0] * bv[0] + a0[1] * bv[1]) + (a0[2] * bv[2] + a0[3] * bv[3]) + (a1[0] * bv[4] + a1[1] * bv[5]) + (a1[2] * bv[6] + a1[3] * bv[7]); } }
            const float* gq = q_norm + (size_t)j * QLORA + rb * 16;
            const float inv = 1.0f / stepL[14 + j];
            float q[16];
#pragma unroll
            for (int i = 0; i < 16; ++i) q[i] = a[i] * gq[i] * QSCALE * inv;
            unsigned char* dst = (unsigned char*)(ws + WS_WQ + j * ATT_W_STRIDE) + (size_t)(h * 256 + cb * 64 + lane) * QLORA + rb * 16;
            *(v4u*)dst = (v4u){pk4_i8(q[0], q[1], q[2], q[3]), pk4_i8(q[4], q[5], q[6], q[7]), pk4_i8(q[8], q[9], q[10], q[11]), pk4_i8(q[12], q[13], q[14], q[15])};
        }
        for (int m = gw; m < M; m += NGW) {
            const f32x4* xr = (const f32x4*)(x + (size_t)m * DM) + lane; float s = 0.f; f32x4 v[8];
#pragma unroll
            for (int j = 0; j < 8; ++j) { v[j] = xr[64 * j]; s += (v[j][0] * v[j][0] + v[j][1] * v[j][1]) + (v[j][2] * v[j][2] + v[j][3] * v[j][3]); }
            s = wave_sum(s);
            v2u* o8 = (v2u*)(HB + (size_t)m * DM) + lane;
#pragma unroll
            for (int j = 0; j < 8; ++j) o8[64 * j] = (v2u){pk2(v[j][0], v[j][1]), pk2(v[j][2], v[j][3])};
            if (lane == 0) RSS[m] = (rss_t)(s * RSS_SCALE);
        }
        }
    }
    if (GROUP_SEAMS && MK_ONE_LAUNCH && IN(PH_PRO) && tid0 == 0) ((unsigned*)(ctl + CW_BAR))[XL_TAB + blockIdx.x] = bar.x + 1u;
    SEAM(PH_PRO);
    if (GROUP_SEAMS && MK_ONE_LAUNCH && IN(PH_PRO) && IN(PH_PRO + 1)) {
        if (wave_s == 0) { const int ln = fresh_tid(0); const unsigned mine = bar.x + 1u;
            const unsigned v = (ln < 32) ? xb_ld(&((unsigned*)(ctl + CW_BAR))[XL_TAB + 8 * ln + (blockIdx.x & 7)]) : mine;
            const bool ok = __all(v == mine) && (MISC[8] == 32u);
            if (ln == 0) MISC[16] = ok ? 1u : 0u; }
        __syncthreads();
    }

    for (int i = 0; i < DEPTH; ++i) {
        const int j = i >> 1;
        const int pb = 1 + j * PH_PER_PAIR + ((i & 1) ? 5 : 0);
        rss_t* rss_mix = RSS + (size_t)(2 * i) * M; rss_t* rss_mlp = RSS + (size_t)(2 * i + 1) * M; rss_t* rss_next = RSS + (size_t)(2 * i + 2) * M;
        int pm;
        if ((i & 1) == 0) {
            bf16* Z = (bf16*)(ws + WS_Z); bf16* U = (bf16*)(ws + WS_U);
            const rss_t* rss_pq = rss_mix - M;
            if (IN(pb + 0)) {
                pg8::StaticOrder S; S.init(M, 4096, G, (int)blockIdx.x);
                if (j >= I8_CONV_FROM) { pg8::Gemm g{(const bf16*)(ws + WS_X8), (const bf16*)(ws + WS_WCA + j * CONV_W_STRIDE), M, 4096, DM, DM, DM, 0}; EpiZI E{Z}; pg8::gemm_phase<EpiZI, pg8::StaticOrder, true, true, PG8_LAYOUT8, 1, true>(lds, g, S, E, wave_s); }
                else { pg8::Gemm g{HB, (const bf16*)(ws + WS_WCA + j * CONV_W_STRIDE), M, 4096, DM, DM, DM, 0}; EpiZ E{Z}; pg8::gemm_phase<EpiZ, pg8::StaticOrder, true, true>(lds, g, S, E, wave_s); }
                { const int tid = fresh_tid(wave_s);
                  if (tid < M / 256) { const int row = 4096 * (int)(blockIdx.x & 7) + (int)(blockIdx.x >> 3) * (M / 256) + tid;   RFV[row] = (j >= I8_CONV_FROM) ? rowf<true>(rss_mix, rss_pq, row) : rowf<false>(rss_mix, nullptr, row); } }
            }
            SEAM_G(pb + 0);
            if (IN(pb + 1)) {
                pg8::StaticOrder S; S.init(M, DM, G, (int)blockIdx.x);
                if (j >= I8_CONV_FROM) { pg8::Gemm g{(const bf16*)(ws + WS_X8), (const bf16*)(ws + WS_WCB + j * CONV_W_STRIDE), M, DM, DM, DM, DM, 0}; EpiUI E{U, Z, conv_w + (size_t)j * 3 * DM, RFV, SBW + 8 + j, SBW + 10 + j};
                    pg8::gemm_phase<EpiUI, pg8::StaticOrder, true, true, PG8_LAYOUT8, 1, true>(lds, g, S, E, wave_s); }
                else { pg8::Gemm g{HB, (const bf16*)(ws + WS_WCB + j * CONV_W_STRIDE), M, DM, DM, DM, DM, 0}; EpiU E{U, Z, conv_w + (size_t)j * 3 * DM, RFV};
                    pg8::gemm_phase<EpiU, pg8::StaticOrder, true, true>(lds, g, S, E, wave_s); }
            }
            SEAM_G(pb + 1);
            if (IN(pb + 2)) {
                pg8::Gemm g{U, (const bf16*)(ws + WS_WCO + j * CONV_W_STRIDE), M, DM, DM, DM, DM, 0}; pg8::StaticOrder S; S.init(M, DM, G, (int)blockIdx.x);
                EpiResX8 E{HB, rss_mlp, nullptr, 1.0f, ws + WS_X8, rss_mix}; pg8::gemm_phase<EpiResX8, pg8::StaticOrder, true, true>(lds, g, S, E, wave_s);
            }
            SEAM_G(pb + 2);
            pm = pb + 3;
        } else {
            float* PROJ = (float*)(ws + WS_PROJ); bf16* CQN = (bf16*)(ws + WS_CQN); bf16* CKV = (bf16*)(ws + WS_CKV); bf16* KIDX = (bf16*)(ws + WS_KIDX); float* WIDX = (float*)(ws + WS_WIDX);
            bf16* QLAT = (bf16*)(ws + WS_QLAT); bf16* QIDX = (bf16*)(ws + WS_QIDX); bf16* IDX = (bf16*)(ws + WS_IDX); bf16* O = (bf16*)(ws + WS_O);
            if (IN(pb + 0)) {
                pg8::Gemm g{(const bf16*)(ws + WS_X8), (const bf16*)(ws + WS_WAI + j * ATT_W_STRIDE), M, INCP, DM, DM, DM, 0}; pg8::StaticOrder S; S.init(M, INCP, G, (int)blockIdx.x);
                EpiProjI E{PROJ, INCP, rss_mix, rss_mix - M, SBW + 12 + j, (unsigned char*)CQN, RSS + (size_t)(9 + j) * M};
                pg8::gemm_phase<EpiProjI, pg8::StaticOrder, true, true, PG8_LAYOUT8, 1, true>(lds, g, S, E, wave_s);
            }
            SEAM_G(pb + 0);
            if (IN(pb + 2)) {
                {
                    PHASE_IDS;
                    const float* kvg = kv_norm + (size_t)j * KVL; const float* lg = ln_g + (size_t)j * IDXD; const float* lb = ln_b + (size_t)j * IDXD;
                    const f32x4 gk = *(const f32x4*)(kvg + 4 * lane); const float lgl = lg[lane], lbl = lb[lane];
                    const int gwl = (int)(blockIdx.x >> 3) * NWAVES + wave, rbase = 4096 * (int)(blockIdx.x & 7);
                    for (int m0 = rbase + gwl; m0 < rbase + 4096; m0 += 2 * 256) {
                        f32x4 kv[2]; float ki[2], wi[2];
#pragma unroll
                        for (int rr = 0; rr < 2; ++rr) { const float* pr = PROJ + (size_t)(m0 + rr * 256) * INCP;
                            kv[rr] = *(const f32x4*)(pr + 512 + 4 * lane); ki[rr] = pr[768 + lane]; wi[rr] = (lane < 16) ? pr[832 + lane] : 0.f; }
#pragma unroll
                        for (int rr = 0; rr < 2; ++rr) { const int m = m0 + rr * 256;
                            float sk = (kv[rr][0] * kv[rr][0] + kv[rr][1] * kv[rr][1]) + (kv[rr][2] * kv[rr][2] + kv[rr][3] * kv[rr][3]);
                            sk = wave_sum(sk);
                            const float rk = rsqrtf(sk * (1.0f / KVL) + EPS);
                            const float mu = wave_sum(ki[rr]) * (1.0f / IDXD); const float dk = ki[rr] - mu; const float var = wave_sum(dk * dk) * (1.0f / IDXD);
                            const float kn = dk * rsqrtf(var + EPS) * lgl + lbl;
                            *(v2u*)(CKV + (size_t)m * KVL + 4 * lane) = (v2u){pk2(kv[rr][0] * rk * gk[0], kv[rr][1] * rk * gk[1]), pk2(kv[rr][2] * rk * gk[2], kv[rr][3] * rk * gk[3])};
                            KIDX[(size_t)m * IDXD + lane] = (bf16)f2bf(kn);
                            if (lane < 16) WIDX[(size_t)m * IDXH + lane] = wi[rr] * 0.03125f; }
                    }
                }
                pg8::Gemm g{CQN, (const bf16*)(ws + WS_WQ + j * ATT_W_STRIDE), M, NQ, QLORA, QLORA, QLORA, 0}; pg8::StaticOrder S; S.init(M, NQ, G, (int)blockIdx.x);
                EpiBf16SI E{QLAT, 4096, QIDX, 1024, 4096, RSS + (size_t)(9 + j) * M, SBW + 14 + j, SBW + 16 + j};
                pg8::gemm_phase<EpiBf16SI, pg8::StaticOrder, true, true, PG8_LAYOUT8, 1, true>(lds, g, S, E, wave_s);
            }
            SEAM_G(pb + 2);
            if (IN(pb + 3)) {
                PHASE_IDS;
                const int grp = blockIdx.x & 7, r = blockIdx.x >> 3;
                for (int u = 0; u < 8; ++u) {
                    const int b = 2 * grp + ((u & 7) >> 2), v = u & 3, qt = (v == 0) ? r : (v == 1) ? 63 - r : (v == 2) ? 64 + r : 127 - r;
                    index_unit(QIDX, KIDX + (size_t)b * SEQ * IDXD, WIDX, IDX, CKV + (size_t)b * SEQ * KVL, QLAT, b, qt, lds, wave_s);
                }
            }
            SEAM_G(pb + 3);
#if 0
            if (IN(pb + 4)) {
                PHASE_IDS;
                const int grp = blockIdx.x & 7, rk = (blockIdx.x >> 3) * NWAVES + wave, nrk = (G >> 3) * NWAVES;
                LAS unsigned char* wl = lds + wave * ATT_WAVE_LDS;
                for (int q = rk; q < 2 * SEQ; q += nrk) {
                    const int row = (2 * grp) * SEQ + q, t = row & (SEQ - 1), b = row >> 11, nsel = (t + 1 < TOPK) ? t + 1 : TOPK;
                    attn_query(CKV + (size_t)b * SEQ * KVL, IDX + (size_t)row * TOPK, QLAT + (size_t)row * 4096, nsel, wl, lane);
                }
                __syncthreads();
            }
            SEAM(pb + 4);
#endif
            if (IN(pb + 5)) {
                pg8::Gemm g{QLAT, (const bf16*)(ws + WS_WUV + j * ATT_W_STRIDE), M, DM, 512, 4096, 512, 512}; pg8::StaticOrder S; S.init(M, DM, G, (int)blockIdx.x);
                if (FP8_AO) { EpiF8 E{(unsigned char*)O, DM, 8.0f}; pg8::gemm_phase<EpiF8, pg8::StaticOrder, true, true>(lds, g, S, E, wave_s); }
                else { EpiBf16 E{O, DM, O, DM, 1 << 30}; pg8::gemm_phase<EpiBf16, pg8::StaticOrder, true, true>(lds, g, S, E, wave_s); }
            }
            SEAM_G(pb + 5);
            if (IN(pb + 6)) {
                pg8::Gemm g{O, (const bf16*)(ws + WS_WAO + j * ATT_W_STRIDE), M, DM, DM, DM, DM, 0}; pg8::StaticOrder S; S.init(M, DM, G, (int)blockIdx.x);
                constexpr int AES = FP8_AO ? 1 : 2; const float cs = FP8_AO ? 1.0f / 512.0f : 1.0f;
                EpiResX8 E{HB, rss_mlp, nullptr, cs, ws + WS_X8, rss_mix}; pg8::gemm_phase<EpiResX8, pg8::StaticOrder, true, true, PG8_LAYOUT8, AES>(lds, g, S, E, wave_s);
            }
            SEAM_G(pb + 6);
            pm = pb + 8;
        }
        bf16* A1 = (bf16*)(ws + (GROUP_SEAMS ? ((i & 1) ? WS_QLAT : WS_BIG + 256 * MiB) : WS_A1));
        if (IN(pm)) {
            pg8::Gemm g{(const bf16*)(ws + WS_X8), (const bf16*)(ws + WS_W1 + i * W1_STRIDE), M, FF, DM, DM, DM, 0}; pg8::StaticOrder S; S.init(M, FF, G, (int)blockIdx.x);
            LAS unsigned char* rcache = lds + 131072 + wave_s * 2304;
            *(LAS int*)(rcache + 2048) = -1;
            EpiRelu2H8 E{(unsigned char*)A1, FF, rss_mlp, rss_mix, SBW + i, rcache};
            pg8::gemm_phase<EpiRelu2H8, pg8::StaticOrder, true, true, PG8_LAYOUT8, 1, true>(lds, g, S, E, wave_s);
        }
        SEAM_G(pm);
        if (IN(pm + 1)) {
            pg8::Gemm g{A1, (const bf16*)(ws + WS_W2 + i * W2_STRIDE), M, DM, FF, FF, FF, 0}; pg8::StaticOrder S; S.init(M, DM, G, (int)blockIdx.x);
            if (i + 1 < DEPTH) { EpiResI E{HB, rss_next, nullptr, 1.0f, ws + WS_X8, rss_mlp, nullptr, COLSUM + i * DM, SBW + 4 + i};
                pg8::gemm_phase<EpiResI, pg8::StaticOrder, true, true, PG8_LAYOUT8, 1, true>(lds, g, S, E, wave_s); }
            else { EpiResIL E{HB, rss_next, nullptr, 1.0f, nullptr, nullptr, nullptr, COLSUM + i * DM, SBW + 4 + i};
                pg8::gemm_phase<EpiResIL, pg8::StaticOrder, true, true, PG8_LAYOUT8, 1, true>(lds, g, S, E, wave_s); }
        }
        if (i + 1 < DEPTH) SEAM(pm + 1); else SEAM_G(pm + 1);
    }

    if (IN(PH_FINAL)) {
        PHASE_IDS;
        const rss_t* rss = RSS + (size_t)8 * M;
        const int gwl = (int)(blockIdx.x >> 3) * NWAVES + wave, rbase = GROUP_SEAMS ? 4096 * (int)(blockIdx.x & 7) : 0, rstep = GROUP_SEAMS ? 256 : NGW, r0 = GROUP_SEAMS ? gwl : gw, rend = GROUP_SEAMS ? 4096 : M;
        for (int m0 = rbase + r0; m0 < rbase + rend; m0 += 2 * rstep) {
            v4u hw[2][4]; float rs[2];
#pragma unroll
            for (int rr = 0; rr < 2; ++rr) { const int m = m0 + rr * rstep; rs[rr] = rstd_of(rss, m); const v4u* hr = (const v4u*)(HB + (size_t)m * DM) + lane;
#pragma unroll
                for (int jj = 0; jj < 4; ++jj) hw[rr][jj] = hr[64 * jj]; }
#pragma unroll
            for (int rr = 0; rr < 2; ++rr) { const int m = m0 + rr * rstep; f32x4* orow = (f32x4*)(args.out + (size_t)m * DM); const f32x4* gr = (const f32x4*)final_norm; const float r1 = rs[rr];
#pragma unroll
                for (int jj = 0; jj < 4; ++jj) { const v4u w4 = hw[rr][jj]; const int c = (64 * jj + lane) * 2; const f32x4 g0 = gr[c], g1 = gr[c + 1];
                    orow[c] = (f32x4){bflo(w4[0]) * r1 * g0[0], bfhi(w4[0]) * r1 * g0[1], bflo(w4[1]) * r1 * g0[2], bfhi(w4[1]) * r1 * g0[3]};
                    orow[c + 1] = (f32x4){bflo(w4[2]) * r1 * g1[0], bfhi(w4[2]) * r1 * g1[1], bflo(w4[3]) * r1 * g1[2], bfhi(w4[3]) * r1 * g1[3]}; } }
        }
    }
#undef IN
#undef SEAM
}

extern "C" void kernel_launch(void* const* d_in, const int* in_sizes, int n_in, void* d_out, int out_size, void* d_ws, size_t ws_size, hipStream_t stream) {
    static int grid = 0; static bool one_launch = false;
    if (grid == 0) {
        if (n_in != 19 || out_size != M * DM || ws_size < WS_END) { fprintf(stderr, "kernel_launch: unexpected shapes (n_in %d out %d ws %zu)\n", n_in, out_size, ws_size); grid = -1; return; }
        int dev = 0, cus = 0, per_cu = 0;
        if (hipGetDevice(&dev) != hipSuccess || hipDeviceGetAttribute(&cus, hipDeviceAttributeMultiprocessorCount, dev) != hipSuccess) { grid = -1; return; }
        if (hipFuncSetAttribute((const void*)fwd, hipFuncAttributeMaxDynamicSharedMemorySize, LDS_BYTES) != hipSuccess) { fprintf(stderr, "kernel_launch: hipFuncSetAttribute failed\n"); grid = -1; return; }
        if (hipOccupancyMaxActiveBlocksPerMultiprocessor(&per_cu, (const void*)fwd, NTHR, LDS_BYTES) != hipSuccess || per_cu < 1) fprintf(stderr, "kernel_launch: occupancy query says %d\n", per_cu);
        (void)hipGetLastError();
        grid = 256; one_launch = (MK_ONE_LAUNCH != 0) && (cus >= 256) && (per_cu >= 1);
    }
    if (grid < 0) return;
    if (hipMemsetAsync((char*)d_ws + WS_CTL, 0, CTL_ZERO_BYTES, stream) != hipSuccess) return;
    Args a{};
    for (int i = 0; i < 19; ++i) a.in[i] = (const float*)d_in[i];
    a.out = (float*)d_out; a.ws = (unsigned char*)d_ws;
    if (one_launch) {
        a.ph_lo = 0; a.ph_hi = N_PHASES;
        hipLaunchKernelGGL(fwd, dim3(grid), dim3(NTHR), LDS_BYTES, stream, a);
    } else {
        for (int p = 0; p < N_PHASES; ++p) {
            const int q = (p - 1) % PH_PER_PAIR;
            if (p >= 1 && p < PH_FINAL && (q == 12 || q == 6 || q == 9)) continue;
            a.ph_lo = p; a.ph_hi = p + 1;
            hipLaunchKernelGGL(fwd, dim3(grid), dim3(NTHR), LDS_BYTES, stream, a);
        }
    }
}
```

```cpp
#include <hip/hip_runtime.h>
#include <cstdio>
#include <cstdint>

#ifndef PG8_LAYOUT8
#define PG8_LAYOUT8 true
#endif
#ifndef ATT_RB
#define ATT_RB 4
#endif
#ifndef ATT_PB
#define ATT_PB 4
#endif
#ifndef GROUP_SEAMS
#define GROUP_SEAMS 1
#endif
#ifndef I8_CONV_FROM
#define I8_CONV_FROM 1
#endif
#ifndef FP8_AO
#define FP8_AO 1
#endif
#ifndef MK_ONE_LAUNCH
#define MK_ONE_LAUNCH 1
#endif

__device__ __forceinline__ int fresh_tid(int wave_s) { unsigned ones = 0xffffffffu; asm volatile("" : "+s"(ones)); return wave_s * 64 + (int)__builtin_amdgcn_mbcnt_hi(ones, __builtin_amdgcn_mbcnt_lo(ones, 0u)); }
namespace pg8 {
#define PG8_LAS __attribute__((address_space(3)))
typedef unsigned short bf16_t;
typedef short bf16x8 __attribute__((ext_vector_type(8)));
typedef float f32x4 __attribute__((ext_vector_type(4)));
typedef unsigned u32x4 __attribute__((ext_vector_type(4)));
typedef unsigned u32x2 __attribute__((ext_vector_type(2)));
typedef int v4i32 __attribute__((ext_vector_type(4)));
typedef int v8i32 __attribute__((ext_vector_type(8)));
constexpr int BM = 256, BK = 64, HALF = 128, HTB = HALF * BK * 2  , STAGE_BYTES = 8 * HTB, NXCD = 8, WGM = 8;

__host__ __device__ __forceinline__ int lds_byte(int r, int c) { const int st = (r >> 4) * 2 + (c >> 5), rr = r & 15, cc = c & 31, ob = rr * 64 + cc * 2; return st * 1024 + (ob ^ (((ob >> 9) & 1) << 5)); }
__host__ __device__ __forceinline__ void stage_rc(int b, int& R, int& C) { const int st = b / 1024, sb = b % 1024, swz = sb ^ (((sb >> 9) & 1) << 5); R = (st >> 1) * 16 + swz / 64; C = (st & 1) * 32 + (swz % 64) / 2; }
__host__ __device__ __forceinline__ int lds_byte8(int r, int c) { return (r >> 3) * 1024 + (r & 7) * 128 + (((c >> 3) ^ (r & 7)) * 16) + (c & 7) * 2; }
__host__ __device__ __forceinline__ void stage_rc8(int b, int& R, int& C) { const int sub = b / 1024, sb = b % 1024, rr = sb / 128, pos = (sb % 128) / 16; R = sub * 8 + rr; C = (pos ^ rr) * 8; }
__host__ __device__ __forceinline__ int perm32(int rho) { const int n = rho >> 4, i = rho & 15; return 8 * (i >> 2) + 4 * n + (i & 3); }

struct Unit { int pm, pn; };
struct Gemm { const bf16_t* A; const bf16_t* Bt; int M, N, K, lda, ldb, akoff; };

struct StaticOrder {
    int nM, nN, nwg, G, c;
    __host__ __device__ void init(int M, int N, int G_, int c_) { nM = M / BM; nN = N / BM; nwg = nM * nN; G = G_; c = c_; }
    __host__ __device__ bool next(int i, Unit& u) const {
        const long L = (long)i * G + c; if (L >= nwg) return false;
        int wgid = (int)L; { const int q = nwg / NXCD, r = nwg % NXCD, xcd = wgid % NXCD, off = wgid / NXCD; wgid = (xcd < r ? xcd * (q + 1) : r * (q + 1) + (xcd - r) * q) + off; }
        const int nig = WGM * nN, gid = wgid / nig, fm = gid * WGM, gsz = (nM - fm) < WGM ? (nM - fm) : WGM;
        u.pm = fm + ((wgid % nig) % gsz); u.pn = (wgid % nig) / gsz; return true;
    }
    __device__ __forceinline__ void a_ready(const Unit&) const {}
    __device__ __forceinline__ void done(const Unit&) const {}
};

__device__ __forceinline__ unsigned cvt_pk_bf16(float lo, float hi) { unsigned r; asm volatile("v_cvt_pk_bf16_f32 %0, %1, %2" : "=v"(r) : "v"(lo), "v"(hi)); return r; }

template <class Epi, class Sched, bool ALIGN_EPI = false, bool SP2 = false, bool LAYOUT8 = PG8_LAYOUT8, int ES = 2, bool I8 = false>
__device__ __forceinline__ void gemm_phase(PG8_LAS unsigned char* lds, const Gemm g, const Sched& S, const Epi& E, int wave_s) {
    const int tid = fresh_tid(wave_s);
    const int wid = __builtin_amdgcn_readfirstlane(tid >> 6), lane = tid & 63, wr = wid >> 2, wc = wid & 3, fr = lane & 15, fq = lane >> 4;
    constexpr bool FP8 = (ES == 1) && !I8; static_assert(ES == 2 || LAYOUT8, "1-byte operands use the line layout"); static_assert(!I8 || ES == 1, "int8 operands are 1 byte");
    const int K = g.K, nt = K / (ES == 1 ? 2 * BK : BK);
    unsigned voffA[2], voffB[2];
#pragma unroll
    for (int i = 0; i < 2; ++i) { int R, C; if (LAYOUT8) stage_rc8(tid * 16 + i * 8192, R, C); else stage_rc(tid * 16 + i * 8192, R, C); const int Rb = (Epi::BMAP == 2) ? (64 * (R >> 5) + 16 * ((R & 15) >> 2) + 4 * ((R >> 4) & 1) + (R & 3)) : (Epi::PERM ? ((R & ~31) + perm32(R & 31)) : R);
        voffA[i] = (unsigned)(R * g.lda * ES + C * 2); voffB[i] = (unsigned)(Rb * g.ldb * ES + C * 2); }
    const size_t kstep = (size_t)(BK * 2);
    const size_t hstepA = (size_t)HALF * g.lda * ES, hstepB = (size_t)((Epi::BMAP == 2) ? 8 : HALF) * g.ldb * ES;
    const size_t tstepA = 2 * hstepA, tstepB = (size_t)BM * g.ldb * ES;
    const size_t akb = (size_t)g.akoff * ES;
    const unsigned ldsw = (unsigned)wid * 1024u;
    const int aoffk[2] = {FP8 ? lds_byte8(wr * 64 + fr, 16 * fq) : LAYOUT8 ? lds_byte8(wr * 64 + fr, fq * 8) : lds_byte(wr * 64 + fr, fq * 8), FP8 ? lds_byte8(wr * 64 + fr, 16 * fq + 8) : LAYOUT8 ? lds_byte8(wr * 64 + fr, 32 + fq * 8) : lds_byte(wr * 64 + fr, fq * 8) + 1024};
    const int boffk[2] = {FP8 ? lds_byte8(wc * 32 + fr, 16 * fq) : LAYOUT8 ? lds_byte8(wc * 32 + fr, fq * 8) : lds_byte(wc * 32 + fr, fq * 8), FP8 ? lds_byte8(wc * 32 + fr, 16 * fq + 8) : LAYOUT8 ? lds_byte8(wc * 32 + fr, 32 + fq * 8) : lds_byte(wc * 32 + fr, fq * 8) + 1024};
#define PG8_SA(b, h) (((b) * 2 + (h)) * HTB)
#define PG8_SB(b, h) ((4 + (b) * 2 + (h)) * HTB)
#define PG8_STAGE(bufoff, gbase, voff) do { _Pragma("unroll") for (int _i = 0; _i < 2; ++_i) { asm volatile("" : "+v"((voff)[_i]));     \
        __builtin_amdgcn_global_load_lds((const unsigned*)((const char*)(gbase) + (voff)[_i]), (PG8_LAS unsigned*)(lds + (bufoff) + ldsw + _i * 8192), 16, 0, 0); } } while (0)
#define PG8_LD8(p0, p1) __builtin_shufflevector(*(const PG8_LAS v4i32*)(p0), *(const PG8_LAS v4i32*)(p1), 0, 1, 2, 3, 4, 5, 6, 7)
#define PG8_LDA(dst, b, h) do { if constexpr (FP8) { _Pragma("unroll") for (int m = 0; m < 4; ++m) dst##8[m] = PG8_LD8(lds + PG8_SA(b, h) + aoffk[0] + m * 2048, lds + PG8_SA(b, h) + aoffk[1] + m * 2048); } else { \
        _Pragma("unroll") for (int m = 0; m < 4; ++m) _Pragma("unroll") for (int k = 0; k < 2; ++k) dst[m][k] = *(const PG8_LAS bf16x8*)(lds + PG8_SA(b, h) + aoffk[k] + m * 2048); } } while (0)
#define PG8_LDB(dst, b, h) do { if constexpr (FP8) { _Pragma("unroll") for (int n = 0; n < 2; ++n) dst##8[n] = PG8_LD8(lds + PG8_SB(b, h) + boffk[0] + n * 2048, lds + PG8_SB(b, h) + boffk[1] + n * 2048); } else { \
        _Pragma("unroll") for (int n = 0; n < 2; ++n) _Pragma("unroll") for (int k = 0; k < 2; ++k) dst[n][k] = *(const PG8_LAS bf16x8*)(lds + PG8_SB(b, h) + boffk[k] + n * 2048); } } while (0)
#define PG8_MMA(ai, bj, At, Bt) do { __builtin_amdgcn_s_setprio(1); if constexpr (FP8) { _Pragma("unroll") for (int m = 0; m < 4; ++m) _Pragma("unroll") for (int n = 0; n < 2; ++n) \
        acc[ai][bj][m][n] = __builtin_amdgcn_mfma_scale_f32_16x16x128_f8f6f4(Bt##8[n], At##8[m], acc[ai][bj][m][n], 0, 0, 0, 0, 0, 0); } else { \
        _Pragma("unroll") for (int m = 0; m < 4; ++m) _Pragma("unroll") for (int n = 0; n < 2; ++n) _Pragma("unroll") for (int k = 0; k < 2; ++k) { \
        if constexpr (I8) acc[ai][bj][m][n] = __builtin_bit_cast(f32x4, __builtin_amdgcn_mfma_i32_16x16x64_i8(__builtin_bit_cast(v4i32, Bt[n][k]), __builtin_bit_cast(v4i32, At[m][k]), __builtin_bit_cast(v4i32, acc[ai][bj][m][n]), 0, 0, 0)); \
        else acc[ai][bj][m][n] = __builtin_amdgcn_mfma_f32_16x16x32_bf16(Bt[n][k], At[m][k], acc[ai][bj][m][n], 0, 0, 0); } } __builtin_amdgcn_s_setprio(0); } while (0)
#define PG8_WAIT_V(n) asm volatile("s_waitcnt vmcnt(" #n ")" ::: "memory")
#define PG8_WAIT_L(n) asm volatile("s_waitcnt lgkmcnt(" #n ")" ::: "memory")
#define PG8_BAR __builtin_amdgcn_s_barrier()
#define PG8_SCHED __builtin_amdgcn_sched_barrier(0)
    Unit cur, nxt; int ui = 0;
    if (!S.next(0, cur)) return;
    f32x4 acc[2][2][4][2];
#pragma unroll
    for (int a = 0; a < 2; ++a)
#pragma unroll
        for (int b = 0; b < 2; ++b)
#pragma unroll
            for (int m = 0; m < 4; ++m)
#pragma unroll
                for (int n = 0; n < 2; ++n) acc[a][b][m][n] = (f32x4){0.f, 0.f, 0.f, 0.f};
    bf16x8 At[4][2], B0[2][2], B1[2][2];
    v8i32 At8[4], B08[2], B18[2];
    const char* cA = (const char*)g.A + (size_t)cur.pm * tstepA + (size_t)cur.pn * akb; const char* cB = (const char*)g.Bt + (size_t)cur.pn * tstepB;
    S.a_ready(cur);
    if constexpr (SP2) {
        PG8_STAGE(PG8_SB(0, 0), cB, voffB); PG8_STAGE(PG8_SB(0, 1), cB + hstepB, voffB); PG8_STAGE(PG8_SA(0, 0), cA, voffA); PG8_STAGE(PG8_SA(0, 1), cA + hstepA, voffA);
        if (wr == 1) PG8_BAR;
        PG8_WAIT_V(2); PG8_BAR;
        PG8_STAGE(PG8_SB(1, 0), cB + kstep, voffB); PG8_STAGE(PG8_SA(1, 0), cA + kstep, voffA); PG8_STAGE(PG8_SB(1, 1), cB + hstepB + kstep, voffB);
        PG8_WAIT_V(6); PG8_BAR;
    } else {
        PG8_STAGE(PG8_SB(0, 0), cB, voffB); PG8_STAGE(PG8_SA(0, 0), cA, voffA); PG8_STAGE(PG8_SB(0, 1), cB + hstepB, voffB); PG8_STAGE(PG8_SA(0, 1), cA + hstepA, voffA);
        if (wr == 1) PG8_BAR;
        PG8_WAIT_V(4); PG8_BAR;
        PG8_STAGE(PG8_SB(1, 0), cB + kstep, voffB); PG8_STAGE(PG8_SA(1, 0), cA + kstep, voffA); PG8_STAGE(PG8_SB(1, 1), cB + hstepB + kstep, voffB);
        PG8_WAIT_V(6); PG8_BAR;
    }
    for (;;) {
        const bool has_next = S.next(ui + 1, nxt);
        const char* nA = has_next ? (const char*)g.A + (size_t)nxt.pm * tstepA + (size_t)nxt.pn * akb : cA; const char* nB = has_next ? (const char*)g.Bt + (size_t)nxt.pn * tstepB : cB;
        for (int t = 0; t < nt; t += 2) {
            const bool last = (t == nt - 2);
            const char* a1 = cA + (size_t)(t + 1) * kstep;
            const char* a2 = last ? nA : cA + (size_t)(t + 2) * kstep; const char* b2 = last ? nB : cB + (size_t)(t + 2) * kstep;
            const char* a3 = a2 + kstep; const char* b3 = b2 + kstep;
            if (last && has_next) S.a_ready(nxt);
            if constexpr (SP2) {
            PG8_LDB(B0, 0, 0); PG8_LDB(B1, 0, 1); PG8_SCHED; PG8_LDA(At, 0, 0); PG8_STAGE(PG8_SA(1, 1), a1 + hstepA, voffA);
            PG8_WAIT_V(8); PG8_WAIT_L(0); PG8_BAR; PG8_MMA(0, 0, At, B0); PG8_MMA(0, 1, At, B1); PG8_BAR; PG8_SCHED;
            PG8_LDA(At, 0, 1); PG8_STAGE(PG8_SB(0, 0), b2, voffB); PG8_STAGE(PG8_SB(0, 1), b2 + hstepB, voffB); PG8_STAGE(PG8_SA(0, 0), a2, voffA);
            PG8_WAIT_V(8); PG8_WAIT_L(0); PG8_BAR; PG8_MMA(1, 0, At, B0); PG8_MMA(1, 1, At, B1); PG8_BAR; PG8_SCHED;
            PG8_LDB(B0, 1, 0); PG8_LDB(B1, 1, 1); PG8_SCHED; PG8_LDA(At, 1, 0); PG8_STAGE(PG8_SA(0, 1), a2 + hstepA, voffA);
            PG8_WAIT_V(8); PG8_WAIT_L(0); PG8_BAR; PG8_MMA(0, 0, At, B0); PG8_MMA(0, 1, At, B1); PG8_BAR; PG8_SCHED;
            PG8_LDA(At, 1, 1); PG8_STAGE(PG8_SB(1, 0), b3, voffB); PG8_STAGE(PG8_SB(1, 1), b3 + hstepB, voffB); PG8_STAGE(PG8_SA(1, 0), a3, voffA);
            PG8_WAIT_V(8); PG8_WAIT_L(0); PG8_BAR; PG8_MMA(1, 0, At, B0); PG8_MMA(1, 1, At, B1); PG8_BAR; PG8_SCHED;
            } else {
            PG8_LDB(B0, 0, 0); PG8_SCHED; PG8_LDA(At, 0, 0); PG8_STAGE(PG8_SA(1, 1), a1 + hstepA, voffA);
            PG8_WAIT_L(8); PG8_BAR; PG8_WAIT_L(0); PG8_MMA(0, 0, At, B0); PG8_BAR; PG8_SCHED;
            PG8_LDB(B1, 0, 1); PG8_STAGE(PG8_SB(0, 0), b2, voffB);
            PG8_BAR; PG8_WAIT_L(0); PG8_MMA(0, 1, At, B1); PG8_BAR;
            PG8_LDA(At, 0, 1); PG8_STAGE(PG8_SA(0, 0), a2, voffA);
            PG8_BAR; PG8_WAIT_L(0); PG8_MMA(1, 0, At, B0); PG8_BAR; PG8_SCHED;
            PG8_STAGE(PG8_SB(0, 1), b2 + hstepB, voffB);
            PG8_WAIT_V(6); PG8_BAR; PG8_MMA(1, 1, At, B1); PG8_BAR;
            PG8_LDB(B0, 1, 0); PG8_SCHED; PG8_LDA(At, 1, 0); PG8_STAGE(PG8_SA(0, 1), a2 + hstepA, voffA);
            PG8_WAIT_L(8); PG8_BAR; PG8_WAIT_L(0); PG8_MMA(0, 0, At, B0); PG8_BAR; PG8_SCHED;
            PG8_LDB(B1, 1, 1); PG8_STAGE(PG8_SB(1, 0), b3, voffB);
            PG8_BAR; PG8_WAIT_L(0); PG8_MMA(0, 1, At, B1); PG8_BAR;
            PG8_LDA(At, 1, 1); PG8_STAGE(PG8_SA(1, 0), a3, voffA);
            PG8_BAR; PG8_WAIT_L(0); PG8_MMA(1, 0, At, B0); PG8_BAR; PG8_SCHED;
            PG8_STAGE(PG8_SB(1, 1), b3 + hstepB, voffB);
            PG8_WAIT_V(6); PG8_BAR; PG8_MMA(1, 1, At, B1); PG8_BAR;
            }
        }
        if constexpr (ALIGN_EPI) { if (wr == 0) PG8_BAR; }
        { const int l2 = fresh_tid(wave_s) & 63; E(acc, cur, wr, wc, l2 & 15, l2 >> 4); }
        S.done(cur);
        if (!has_next) break;
#pragma unroll
        for (int a = 0; a < 2; ++a)
#pragma unroll
            for (int b = 0; b < 2; ++b)
#pragma unroll
                for (int m = 0; m < 4; ++m)
#pragma unroll
                    for (int n = 0; n < 2; ++n) acc[a][b][m][n] = (f32x4){0.f, 0.f, 0.f, 0.f};
        cur = nxt; cA = nA; cB = nB; ++ui;
        if constexpr (ALIGN_EPI) { if (wr == 1) PG8_BAR; }
    }
    PG8_WAIT_V(0);
    if constexpr (!ALIGN_EPI) { if (wr == 0) PG8_BAR; }
    PG8_BAR;
#undef PG8_SA
#undef PG8_SB
#undef PG8_STAGE
#undef PG8_LDA
#undef PG8_LDB
#undef PG8_MMA
#undef PG8_LD8
#undef PG8_WAIT_V
#undef PG8_WAIT_L
#undef PG8_BAR
#undef PG8_SCHED
}
}

constexpr int NWAVES = 8, NTHR = NWAVES * 64;
constexpr int BATCH = 16, SEQ = 2048, DM = 2048, DEPTH = 4, FF = 8192;
constexpr int M = BATCH * SEQ;
constexpr int NHEAD = 16, QLORA = 512, KVL = 256, IDXD = 64, IDXH = 16, TOPK = 256, INC = 848, INCP = 1024;
constexpr int NQ = NHEAD * KVL + IDXH * IDXD;
constexpr float EPS = 1e-6f;
constexpr float QSCALE = 0.08838834764831845f * 1.4426950408889634f;

constexpr size_t MiB = 1u << 20;
constexpr size_t WS_CTL = 0, CTL_ZERO_BYTES = 4 * MiB;
constexpr size_t WS_RSS = 1 * MiB;
constexpr size_t WS_SBW = 3 * MiB + 768 * 1024;
constexpr size_t WS_WCA = 4 * MiB;
constexpr size_t WS_WCB = WS_WCA + 16 * MiB, WS_WCO = WS_WCA + 24 * MiB, CONV_W_STRIDE = 32 * MiB;
constexpr size_t WS_W1 = 68 * MiB, W1_STRIDE = 16 * MiB, WS_W2 = 132 * MiB, W2_STRIDE = 32 * MiB;
constexpr size_t WS_X8 = 260 * MiB;
constexpr size_t WS_WAI = 324 * MiB;
constexpr size_t WS_WQ = WS_WAI + 4 * MiB, WS_WUV = WS_WAI + 9 * MiB, WS_WAO = WS_WAI + 11 * MiB, ATT_W_STRIDE = 19 * MiB;
constexpr size_t WS_HB = 362 * MiB;
constexpr size_t WS_BIG = 490 * MiB;
constexpr size_t WS_A1 = WS_BIG;
constexpr size_t WS_Z = WS_BIG, WS_U = WS_BIG + 128 * MiB;
constexpr size_t WS_PROJ = WS_BIG;
constexpr size_t WS_O = WS_BIG + 384 * MiB;
static_assert(FP8_AO == 1, "the bf16 O buffer would not fit over q_idx");
constexpr size_t WS_QLAT = WS_BIG + 128 * MiB;
constexpr size_t WS_QIDX = WS_QLAT + 256 * MiB;
constexpr size_t WS_CQN = WS_QIDX + 64 * MiB;
constexpr size_t WS_CKV = WS_CQN + 32 * MiB;
constexpr size_t WS_KIDX = WS_CKV + 16 * MiB;
constexpr size_t WS_WIDX = WS_KIDX + 4 * MiB;
constexpr size_t WS_IDX = WS_WIDX + 2 * MiB;
constexpr size_t WS_END = 1024 * MiB;
static_assert(WS_IDX + 16 * MiB <= WS_END && WS_A1 + 512 * MiB <= WS_END && WS_WAI + 2 * ATT_W_STRIDE <= WS_HB && WS_W1 + 4 * W1_STRIDE <= WS_W2 && WS_W2 + 4 * W2_STRIDE <= WS_X8 && WS_X8 + 64 * MiB <= WS_WAI && WS_WCA + 2 * CONV_W_STRIDE <= WS_W1, "d_ws map");
constexpr int CW_TMO = 0, CW_CODE = 1, CW_BAR = 4096;

constexpr int LDS_PHASE_BYTES = 151552;
constexpr int LDSCTL_OFF = LDS_PHASE_BYTES, LDS_BYTES = LDSCTL_OFF + 512;

#define GAS __attribute__((address_space(1)))
#define LAS __attribute__((address_space(3)))
typedef unsigned short bf16;
typedef unsigned v4u __attribute__((ext_vector_type(4)));
typedef unsigned v2u __attribute__((ext_vector_type(2)));
typedef float f32x4 __attribute__((ext_vector_type(4)));
typedef GAS unsigned gu32;
#define RLX_AGENT __ATOMIC_RELAXED, __HIP_MEMORY_SCOPE_AGENT
#define LDS_WAIT() asm volatile("s_waitcnt lgkmcnt(0)" ::: "memory")
#define VM_WAIT() asm volatile("s_waitcnt vmcnt(0)" ::: "memory")
__device__ __forceinline__ unsigned f2bf(float f) { unsigned u = __builtin_bit_cast(unsigned, f); return (u + 0x7fffu + ((u >> 16) & 1u)) >> 16; }
__device__ __forceinline__ unsigned pk2(float lo, float hi) { return f2bf(lo) | (f2bf(hi) << 16); }
__device__ __forceinline__ float bflo(unsigned w) { return __builtin_bit_cast(float, w << 16); }
__device__ __forceinline__ float bfhi(unsigned w) { return __builtin_bit_cast(float, w & 0xffff0000u); }
__device__ __forceinline__ float bf2f(bf16 h) { return __builtin_bit_cast(float, (unsigned)h << 16); }

#define XB_TMO      128
#define XB_XCNT(j)  (256  + 64 * (j))
#define XB_XSUB(j)  (1280 + 64 * (j))
#define XB_XGEN(j)  (2304 + 64 * (j))
#define XB_TOP      3328
#define XB_TOPGEN   3392
#define XCD_BAR_WORDS 3456
#define XB_SPIN_CAP (1u << 18)
__device__ __forceinline__ unsigned xb_ld(unsigned* p)              { return __hip_atomic_load(p, __ATOMIC_RELAXED, __HIP_MEMORY_SCOPE_AGENT); }
__device__ __forceinline__ unsigned xb_add(unsigned* p, unsigned v) { return __hip_atomic_fetch_add(p, v, __ATOMIC_RELAXED, __HIP_MEMORY_SCOPE_AGENT); }
__device__ __forceinline__ unsigned xb_xcc_id() { return (unsigned)__builtin_amdgcn_s_getreg((3 << 11) | 20) & 0xFu; }
#define XB_SPIN(cond, bar) do { unsigned _sp = 0; while (cond) { __builtin_amdgcn_s_sleep(1); \
    if ((++_sp & 255u) == 0u) { if (xb_ld(&(bar)[XB_TMO])) break; if (_sp > XB_SPIN_CAP) { atomicAdd(&(bar)[XB_TMO], 1u); break; } } } } while (0)
struct XcdBarrier { unsigned* bar; unsigned x; volatile LAS unsigned* st; int wave_s; };
__device__ __forceinline__ XcdBarrier xcd_barrier_post(unsigned* bar, volatile LAS unsigned* st, int wave_s) {
    XcdBarrier b; b.bar = bar; b.x = xb_xcc_id(); b.st = st; b.wave_s = wave_s;
    if (fresh_tid(wave_s) == 0) (void)xb_add(&bar[XB_XCNT(b.x)], 1u);
    return b;
}
__device__ __forceinline__ void xcd_barrier_complete(unsigned* bar, unsigned x, unsigned& nloc, unsigned& nx) {
    const unsigned G = gridDim.x * gridDim.y * gridDim.z;
    unsigned sum, cnt, mine, sp = 0u;
    for (;;) {
        sum = 0u; cnt = 0u; mine = 0u;
#pragma unroll
        for (unsigned j = 0; j < 16; ++j) { const unsigned c = xb_ld(&bar[XB_XCNT(j)]); sum += c; cnt += (c > 0u) ? 1u : 0u; mine = (j == x) ? c : mine; }
        if (sum == G) break;
        __builtin_amdgcn_s_sleep(1);
        if ((++sp & 255u) == 0u) { if (xb_ld(&bar[XB_TMO])) break; if (sp > XB_SPIN_CAP) { atomicAdd(&bar[XB_TMO], 1u); break; } }
    }
    nloc = mine > 0u ? mine : 1u; nx = cnt > 0u ? cnt : 1u;
}
__device__ __forceinline__ void xcd_barrier(const XcdBarrier& b) {
    asm volatile("s_waitcnt vmcnt(0)" ::: "memory");
    __syncthreads();
    if (fresh_tid(b.wave_s) == 0) {
        unsigned* bar = b.bar;
        __builtin_amdgcn_s_waitcnt(0);
        unsigned nloc = b.st[0], nx = b.st[1];
        if (nloc == 0u) { xcd_barrier_complete(bar, b.x, nloc, nx); b.st[0] = nloc; b.st[1] = nx; }
        const unsigned old = xb_add(&bar[XB_XSUB(b.x)], 1u);
        const unsigned gen = old / nloc;
        if (old + 1u == (gen + 1u) * nloc) {
            __builtin_amdgcn_fence(__ATOMIC_RELEASE, "agent");
            asm volatile("s_waitcnt vmcnt(0)" ::: "memory");
            const unsigned og = xb_add(&bar[XB_TOP], 1u);
            const unsigned tg = og / nx;
            if (og + 1u == (tg + 1u) * nx) xb_add(&bar[XB_TOPGEN], 1u);
            else XB_SPIN(xb_ld(&bar[XB_TOPGEN]) == tg, bar);
            __builtin_amdgcn_fence(__ATOMIC_ACQUIRE, "agent");
            xb_add(&bar[XB_XGEN(b.x)], 1u);
            asm volatile("s_waitcnt vmcnt(0)" ::: "memory");
        } else {
            XB_SPIN(xb_ld(&bar[XB_XGEN(b.x)]) == gen, bar);
            __builtin_amdgcn_fence(__ATOMIC_ACQUIRE, "agent");
            asm volatile("s_waitcnt vmcnt(0)" ::: "memory");
        }
    }
    __syncthreads();
}

#define GB_WORD(g) (XCD_BAR_WORDS + 128 + 64 * (g))
__device__ __forceinline__ void grp_barrier(unsigned* bar, int grp, int wave_s) {
    asm volatile("s_waitcnt vmcnt(0)" ::: "memory");
    __syncthreads();
    if (fresh_tid(wave_s) == 0) {
        unsigned* cnt = bar + GB_WORD(grp);
        __builtin_amdgcn_fence(__ATOMIC_RELEASE, "agent");
        asm volatile("s_waitcnt vmcnt(0)" ::: "memory");
        const unsigned old = xb_add(cnt, 1u), target = (old / 32u + 1u) * 32u;
        XB_SPIN(xb_ld(cnt) < target, bar);
        __builtin_amdgcn_fence(__ATOMIC_ACQUIRE, "agent");
        asm volatile("s_waitcnt vmcnt(0)" ::: "memory");
    }
    __syncthreads();
}

#define XL_CNT(x) (XCD_BAR_WORDS + 1024 + 64 * (x))
#define XL_GEN(x) (XCD_BAR_WORDS + 2048 + 64 * (x))
#define XL_TAB    (XCD_BAR_WORDS + 3072)
__device__ __forceinline__ void grp_barrier_fast(unsigned* bar, unsigned x, int wave_s) {
    asm volatile("s_waitcnt vmcnt(0)" ::: "memory");
    __syncthreads();
    if (fresh_tid(wave_s) == 0) {
        const unsigned old = xb_add(&bar[XL_CNT(x)], 1u), gen = old / 32u;
        if (old + 1u == (gen + 1u) * 32u) {
            __builtin_amdgcn_fence(__ATOMIC_ACQUIRE, "agent");
            xb_add(&bar[XL_GEN(x)], 1u);
            asm volatile("s_waitcnt vmcnt(0)" ::: "memory");
        } else {
            XB_SPIN(xb_ld(&bar[XL_GEN(x)]) == gen, bar);
            __builtin_amdgcn_fence(__ATOMIC_ACQUIRE, "agent");
            asm volatile("s_waitcnt vmcnt(0)" ::: "memory");
        }
    }
    __syncthreads();
}

using pg8::Unit; using pg8::cvt_pk_bf16; using pg8::HALF;
typedef pg8::f32x4 accT[2][2][4][2];
typedef unsigned long long rss_t;
constexpr float RSS_SCALE = 16777216.0f;
__device__ __forceinline__ float rstd_raw(rss_t v) { return rsqrtf((float)v * (1.0f / (RSS_SCALE * DM)) + EPS); }
__device__ __forceinline__ float ms_raw(rss_t v) { return (float)v * (1.0f / (RSS_SCALE * DM)) + EPS; }
__device__ __forceinline__ float rstd_of(const rss_t* rss, int r) { return rsqrtf((float)rss[r] * (1.0f / (RSS_SCALE * DM)) + EPS); }

__device__ __forceinline__ unsigned pk4_fp8(float a, float b, float c, float d) { int w = 0; w = __builtin_amdgcn_cvt_pk_fp8_f32(a, b, w, false); w = __builtin_amdgcn_cvt_pk_fp8_f32(c, d, w, true); return (unsigned)w; }
constexpr float QC = 22.0f, WCLIP = 4.2f;
__device__ __forceinline__ float ms_of(const rss_t* rss, int r) { return (float)rss[r] * (1.0f / (RSS_SCALE * DM)) + EPS; }
__device__ __forceinline__ unsigned pk4_i8(float a, float b, float c, float d) {
    unsigned w = 0;
    w = __builtin_amdgcn_cvt_pk_u8_f32(a + 128.0f, 0, w); w = __builtin_amdgcn_cvt_pk_u8_f32(b + 128.0f, 1, w);
    w = __builtin_amdgcn_cvt_pk_u8_f32(c + 128.0f, 2, w); w = __builtin_amdgcn_cvt_pk_u8_f32(d + 128.0f, 3, w);
    return w ^ 0x80808080u;
}
constexpr float HCLIP = 20.0f;
struct EpiRelu2H8 {
    static constexpr bool PERM = true; static constexpr int BMAP = 2;
    unsigned char* O; int ldc; const rss_t* rss; const rss_t* rss_q; const float* sbw; LAS unsigned char* cache;
    __device__ __forceinline__ void operator()(const accT& acc, const Unit& u, int wr, int wc, int fr, int fq) const {
        const int row0 = u.pm * 256 + wr * 64 + fr, col0 = u.pn * 256 + 64 * wc + 16 * fq; float kc = 3.570714214f / QC; asm volatile("" : "+s"(kc));
        const float sb = *sbw * kc;
        const int l64 = (fr + 16 * fq) & 63; LAS float* slot = (LAS float*)(cache + 32 * l64); LAS int* tagp = (LAS int*)(cache + 2048);
        float rs8[2][4];
        if (__builtin_amdgcn_readfirstlane(*tagp) != u.pm) {
            rss_t ra[2][4], rb[2][4];
#pragma unroll
            for (int ai = 0; ai < 2; ++ai)
#pragma unroll
                for (int m = 0; m < 4; ++m) { const int r = row0 + ai * HALF + m * 16; ra[ai][m] = rss[r]; rb[ai][m] = rss_q[r]; }
            __builtin_amdgcn_sched_barrier(0);
#pragma unroll
            for (int ai = 0; ai < 2; ++ai)
#pragma unroll
                for (int m = 0; m < 4; ++m) rs8[ai][m] = rstd_raw(ra[ai][m]) * sqrtf(ms_raw(rb[ai][m])) * sb;
            *(LAS f32x4*)slot = (f32x4){rs8[0][0], rs8[0][1], rs8[0][2], rs8[0][3]}; *(LAS f32x4*)(slot + 4) = (f32x4){rs8[1][0], rs8[1][1], rs8[1][2], rs8[1][3]};
            *tagp = u.pm;
        } else {
            const f32x4 c0 = *(const LAS f32x4*)slot, c1 = *(const LAS f32x4*)(slot + 4);
#pragma unroll
            for (int m = 0; m < 4; ++m) { rs8[0][m] = c0[m]; rs8[1][m] = c1[m]; }
        }
#pragma unroll
        for (int ai = 0; ai < 2; ++ai) {
            float rsv[4];
#pragma unroll
            for (int m = 0; m < 4; ++m) rsv[m] = rs8[ai][m];
#pragma unroll
            for (int m = 0; m < 4; ++m) { const int r = row0 + ai * HALF + m * 16; const float rs = rsv[m]; unsigned wd[4];
#pragma unroll
                for (int bj = 0; bj < 2; ++bj)
#pragma unroll
                    for (int n = 0; n < 2; ++n) { const pg8::f32x4 a4 = acc[ai][bj][m][n]; float q[4];
#pragma unroll
                        for (int e = 0; e < 4; ++e) { const float x = a4[e]; const float v = (float)__float_as_int(x) * rs; q[e] = v * fmaxf(v, 0.f); }
                        unsigned w = 0; w = __builtin_amdgcn_cvt_pk_u8_f32(q[0], 0, w); w = __builtin_amdgcn_cvt_pk_u8_f32(q[1], 1, w); w = __builtin_amdgcn_cvt_pk_u8_f32(q[2], 2, w); w = __builtin_amdgcn_cvt_pk_u8_f32(q[3], 3, w);
                        wd[2 * bj + n] = w ^ 0x80808080u; }
                *(pg8::u32x4*)(O + (size_t)r * ldc + col0) = (pg8::u32x4){wd[0], wd[1], wd[2], wd[3]}; }
            asm volatile("" ::: "memory");
        }
    }
};
struct EpiF8 {
    static constexpr bool PERM = true; static constexpr int BMAP = 2;
    unsigned char* O; int ldc; float sc;
    __device__ __forceinline__ void operator()(const accT& acc, const Unit& u, int wr, int wc, int fr, int fq) const {
        const int row0 = u.pm * 256 + wr * 64 + fr, col0 = u.pn * 256 + 64 * wc + 16 * fq;
#pragma unroll
        for (int ai = 0; ai < 2; ++ai)
#pragma unroll
            for (int m = 0; m < 4; ++m) { const int r = row0 + ai * HALF + m * 16; unsigned wd[4];
#pragma unroll
                for (int bj = 0; bj < 2; ++bj)
#pragma unroll
                    for (int n = 0; n < 2; ++n) { const pg8::f32x4 v = acc[ai][bj][m][n] * sc; wd[2 * bj + n] = pk4_fp8(v[0], v[1], v[2], v[3]); }
                *(pg8::u32x4*)(O + (size_t)r * ldc + col0) = (pg8::u32x4){wd[0], wd[1], wd[2], wd[3]}; }
    }
};
template <bool ACCI> __device__ __forceinline__ pg8::f32x4 acc_f(const pg8::f32x4 a) {
    if constexpr (ACCI) { const float x0 = a[0], x1 = a[1], x2 = a[2], x3 = a[3]; return (pg8::f32x4){(float)__float_as_int(x0), (float)__float_as_int(x1), (float)__float_as_int(x2), (float)__float_as_int(x3)}; }
    else return a;
}
constexpr float CQSC = 127.0f / 5.5f;
template <bool RS, bool ACCI = false> struct EpiBf16T {
    static constexpr bool PERM = true; static constexpr int BMAP = 1;
    bf16* O; int ldc; bf16* O2; int ldc2; int split; const rss_t* rsq = nullptr; const float* step1 = nullptr; const float* step2 = nullptr;
    __device__ __forceinline__ void operator()(const accT& acc, const Unit& u, int wr, int wc, int fr, int fq) const {
        if constexpr (ACCI) asm volatile("" ::: "memory");
        int colt = u.pn * 256; bf16* base = O; int ld = ldc; float cst = 1.0f; if constexpr (ACCI) cst = *step1 * (1.0f / CQSC);
        if (colt >= split) { colt -= split; base = O2; ld = ldc2; if constexpr (ACCI) cst = *step2 * (1.0f / CQSC); }
        const int row0 = u.pm * 256 + wr * 64 + fr, col0 = colt + wc * 32 + 8 * fq;
        float rsv[2][4]; rss_t rraw[2][4];
#pragma unroll
        for (int ai = 0; ai < 2; ++ai)
#pragma unroll
            for (int m = 0; m < 4; ++m) { rsv[ai][m] = cst; if constexpr (RS) rraw[ai][m] = rsq[row0 + ai * HALF + m * 16]; }
        if constexpr (RS) { __builtin_amdgcn_sched_barrier(0);
#pragma unroll
            for (int ai = 0; ai < 2; ++ai)
#pragma unroll
                for (int m = 0; m < 4; ++m) rsv[ai][m] *= rsqrtf((float)rraw[ai][m] * (1.0f / (RSS_SCALE * QLORA)) + EPS); }
#pragma unroll
        for (int ai = 0; ai < 2; ++ai)
#pragma unroll
            for (int m = 0; m < 4; ++m) { bf16* rowp = base + (size_t)(row0 + ai * HALF + m * 16) * ld + col0;
                const float rs = rsv[ai][m];
#pragma unroll
                for (int bj = 0; bj < 2; ++bj) { pg8::f32x4 v0 = acc_f<ACCI>(acc[ai][bj][m][0]), v1 = acc_f<ACCI>(acc[ai][bj][m][1]); if constexpr (RS || ACCI) { v0 = v0 * rs; v1 = v1 * rs; }
                    pg8::u32x4 w; w.x = cvt_pk_bf16(v0[0], v0[1]); w.y = cvt_pk_bf16(v0[2], v0[3]); w.z = cvt_pk_bf16(v1[0], v1[1]); w.w = cvt_pk_bf16(v1[2], v1[3]);
                    *(pg8::u32x4*)(rowp + bj * HALF) = w; } }
    }
};
typedef EpiBf16T<false> EpiBf16; typedef EpiBf16T<true> EpiBf16S; typedef EpiBf16T<true, true> EpiBf16SI;
template <bool ACCI> __device__ __forceinline__ float rowf(const rss_t* rss, const rss_t* rss_q, int r) {
    float f = rstd_of(rss, r); if constexpr (ACCI) f *= sqrtf(ms_of(rss_q, r)) * (1.0f / QC); return f;
}
template <bool ACCI> struct EpiRowScaleF32T {
    static constexpr bool PERM = false; static constexpr int BMAP = 0;
    float* C; int ldc; const rss_t* rss; const rss_t* rss_q = nullptr; const float* stepw = nullptr;
    __device__ __forceinline__ void operator()(const accT& acc, const Unit& u, int wr, int wc, int fr, int fq) const {
        const int row0 = u.pm * 256 + wr * 64 + fr, col0 = u.pn * 256 + wc * 32 + 4 * fq;
#pragma unroll
        for (int ai = 0; ai < 2; ++ai)
#pragma unroll
            for (int m = 0; m < 4; ++m) { const int r = row0 + ai * HALF + m * 16; const float rs = rowf<ACCI>(rss, rss_q, r) * (ACCI ? *stepw : 1.0f); float* rowp = C + (size_t)r * ldc + col0;
#pragma unroll
                for (int bj = 0; bj < 2; ++bj)
#pragma unroll
                    for (int n = 0; n < 2; ++n) *(pg8::f32x4*)(rowp + bj * HALF + n * 16) = acc_f<ACCI>(acc[ai][bj][m][n]) * rs; }
    }
};
typedef EpiRowScaleF32T<false> EpiRowScaleF32; typedef EpiRowScaleF32T<true> EpiRowScaleF32I;
struct EpiProjI {
    static constexpr bool PERM = false; static constexpr int BMAP = 0;
    float* C; int ldc; const rss_t* rss; const rss_t* rss_q; const float* stepw; unsigned char* CQN; rss_t* rsq_out;
    __device__ __forceinline__ void operator()(const accT& acc, const Unit& u, int wr, int wc, int fr, int fq) const {
        const int row0 = u.pm * 256 + wr * 64 + fr, col0 = u.pn * 256 + wc * 32 + 4 * fq; const float st = *stepw;
        if (u.pn < 2) {
#pragma unroll
            for (int ai = 0; ai < 2; ++ai) {
                float rsv[4]; rss_t ra[4], rb[4];
#pragma unroll
                for (int m = 0; m < 4; ++m) { const int r = row0 + ai * HALF + m * 16; ra[m] = rss[r]; rb[m] = rss_q[r]; }
                __builtin_amdgcn_sched_barrier(0);
#pragma unroll
                for (int m = 0; m < 4; ++m) rsv[m] = rstd_raw(ra[m]) * sqrtf(ms_raw(rb[m])) * (st * CQSC / QC);
#pragma unroll
                for (int m = 0; m < 4; ++m) { const int r = row0 + ai * HALF + m * 16; const float rs = rsv[m]; unsigned char* rowp = CQN + (size_t)r * QLORA + col0; float ss = 0.f;
#pragma unroll
                    for (int bj = 0; bj < 2; ++bj)
#pragma unroll
                        for (int n = 0; n < 2; ++n) { const pg8::f32x4 v = acc_f<true>(acc[ai][bj][m][n]) * rs; float t[4];
#pragma unroll
                            for (int e = 0; e < 4; ++e) { const float x = v[e]; t[e] = fminf(fmaxf(__builtin_rintf(x), -128.0f), 127.0f); ss += t[e] * t[e]; }
                            *(unsigned*)(rowp + bj * HALF + n * 16) = pk4_i8(t[0], t[1], t[2], t[3]); }
                    ss += __shfl_xor(ss, 16); ss += __shfl_xor(ss, 32);
                    if (fq == 0) atomicAdd(rsq_out + r, (rss_t)(ss * (RSS_SCALE / (CQSC * CQSC)))); }
                asm volatile("" ::: "memory"); }
        } else {
#pragma unroll
            for (int ai = 0; ai < 2; ++ai) {
                float rsv[4]; rss_t ra[4], rb[4];
#pragma unroll
                for (int m = 0; m < 4; ++m) { const int r = row0 + ai * HALF + m * 16; ra[m] = rss[r]; rb[m] = rss_q[r]; }
                __builtin_amdgcn_sched_barrier(0);
#pragma unroll
                for (int m = 0; m < 4; ++m) rsv[m] = rstd_raw(ra[m]) * sqrtf(ms_raw(rb[m])) * (st / QC);
#pragma unroll
                for (int m = 0; m < 4; ++m) { const int r = row0 + ai * HALF + m * 16; const float rs = rsv[m]; float* rowp = C + (size_t)r * ldc + col0;
#pragma unroll
                    for (int bj = 0; bj < 2; ++bj)
#pragma unroll
                        for (int n = 0; n < 2; ++n) *(pg8::f32x4*)(rowp + bj * HALF + n * 16) = acc_f<true>(acc[ai][bj][m][n]) * rs; }
                asm volatile("" ::: "memory"); }
        }
    }
};
template <bool ACCI> struct EpiZT {
    static constexpr bool PERM = true; static constexpr int BMAP = 1;
    bf16* Z;
    __device__ __forceinline__ void operator()(const accT& acc, const Unit& u, int wr, int wc, int fr, int fq) const {
        const int row0 = u.pm * 256 + wr * 64 + fr, col0 = u.pn * 128 + wc * 32 + 8 * fq;
#pragma unroll
        for (int ai = 0; ai < 2; ++ai)
#pragma unroll
            for (int m = 0; m < 4; ++m) { const int r = row0 + ai * HALF + m * 16;
                const pg8::f32x4 v0 = acc_f<ACCI>(acc[ai][0][m][0]) * acc_f<ACCI>(acc[ai][1][m][0]), v1 = acc_f<ACCI>(acc[ai][0][m][1]) * acc_f<ACCI>(acc[ai][1][m][1]);
                pg8::u32x4 w; w.x = cvt_pk_bf16(v0[0], v0[1]); w.y = cvt_pk_bf16(v0[2], v0[3]); w.z = cvt_pk_bf16(v1[0], v1[1]); w.w = cvt_pk_bf16(v1[2], v1[3]);
                *(pg8::u32x4*)(Z + (size_t)r * DM + col0) = w; }
    }
};
typedef EpiZT<false> EpiZ; typedef EpiZT<true> EpiZI;
template <bool ACCI> struct EpiUT {
    static constexpr bool PERM = true; static constexpr int BMAP = 1;
    bf16* U; const bf16* Z; const float* cw; const float* rfp; const float* step_a = nullptr; const float* step_b = nullptr;
    __device__ __forceinline__ void operator()(const accT& acc, const Unit& u, int wr, int wc, int fr, int fq) const {
        const int row0 = u.pm * 256 + wr * 64 + fr; const float sa = ACCI ? *step_a : 1.0f, sbb = ACCI ? *step_b : 1.0f;
#pragma unroll
        for (int bj = 0; bj < 2; ++bj) { const int col0 = u.pn * 256 + bj * HALF + wc * 32 + 8 * fq;
            float w0[8], w1[8], w2[8];
#pragma unroll
            for (int e = 0; e < 8; ++e) { w0[e] = cw[col0 + e]; w1[e] = cw[DM + col0 + e]; w2[e] = cw[2 * DM + col0 + e]; }
#pragma unroll
            for (int ai = 0; ai < 2; ++ai)
#pragma unroll
                for (int m = 0; m < 4; ++m) { const int r = row0 + ai * HALF + m * 16, t = r & (SEQ - 1);
                    const int r1 = (t >= 1) ? r - 1 : r, r2 = (t >= 2) ? r - 2 : r;
                    const float f0 = rfp[r], f1 = rfp[r1], f2 = rfp[r2];
                    const v4u z2 = *(const v4u*)(Z + (size_t)r * DM + col0), z1 = *(const v4u*)(Z + (size_t)r1 * DM + col0), z0 = *(const v4u*)(Z + (size_t)r2 * DM + col0);
                    __builtin_amdgcn_sched_barrier(0);
                    const float rs = f0 * sbb, ra = f0 * sa, qa = (t >= 1) ? f1 * sa : 0.f, qb = (t >= 2) ? f2 * sa : 0.f;
                    const float s2 = ra * ra, s1 = qa * qa, s0 = qb * qb;
                    float o[8];
#pragma unroll
                    for (int e2 = 0; e2 < 4; ++e2) {
                        const float c0 = w0[2 * e2] * s0 * bflo(z0[e2]) + w1[2 * e2] * s1 * bflo(z1[e2]) + w2[2 * e2] * s2 * bflo(z2[e2]);
                        const float c1 = w0[2 * e2 + 1] * s0 * bfhi(z0[e2]) + w1[2 * e2 + 1] * s1 * bfhi(z1[e2]) + w2[2 * e2 + 1] * s2 * bfhi(z2[e2]);
                        const pg8::f32x4 g0 = acc_f<ACCI>(acc[ai][bj][m][0]), g1 = acc_f<ACCI>(acc[ai][bj][m][1]);
                        const float b0 = (e2 < 2 ? g0[2 * e2] : g1[2 * e2 - 4]) * rs;
                        const float b1 = (e2 < 2 ? g0[2 * e2 + 1] : g1[2 * e2 - 3]) * rs;
                        o[2 * e2] = b0 * c0; o[2 * e2 + 1] = b1 * c1; }
                    pg8::u32x4 w; w.x = cvt_pk_bf16(o[0], o[1]); w.y = cvt_pk_bf16(o[2], o[3]); w.z = cvt_pk_bf16(o[4], o[5]); w.w = cvt_pk_bf16(o[6], o[7]);
                    *(pg8::u32x4*)(U + (size_t)r * DM + col0) = w; } }
    }
};
typedef EpiUT<false> EpiU; typedef EpiUT<true> EpiUI;
template <bool X8OUT, bool ACCI = false> struct EpiResT {
    static constexpr bool PERM = true; static constexpr int BMAP = 1;
    bf16* HB; rss_t* rss_out; const rss_t* rs2_in; float cscale; unsigned char* X8 = nullptr; const rss_t* rss_q = nullptr; const rss_t* rq_in = nullptr; const int* colsum = nullptr; const float* stepw = nullptr;
    __device__ __forceinline__ void operator()(const accT& acc, const Unit& u, int wr, int wc, int fr, int fq) const {
        const int row0 = u.pm * 256 + wr * 64 + fr, col0 = u.pn * 256 + wc * 32 + 8 * fq;
        float ssv[2][4];
        int zc[2][8]; float ics = 0.f;
        if constexpr (ACCI) { ics = *stepw * (HCLIP / 255.0f);
#pragma unroll
            for (int bj = 0; bj < 2; ++bj) { const pg8::u32x4 c0 = *(const pg8::u32x4*)(colsum + col0 + bj * HALF), c1 = *(const pg8::u32x4*)(colsum + col0 + bj * HALF + 4);
#pragma unroll
                for (int e = 0; e < 4; ++e) { zc[bj][e] = (int)c0[e] * 128; zc[bj][4 + e] = (int)c1[e] * 128; } } }

#pragma unroll
        for (int ai = 0; ai < 2; ++ai) {
            pg8::u32x4 hw[4][2]; float sc2[4], qs[4];
#pragma unroll
            for (int m = 0; m < 4; ++m)
#pragma unroll
                for (int bj = 0; bj < 2; ++bj) hw[m][bj] = *(const pg8::u32x4*)(HB + (size_t)(row0 + ai * HALF + m * 16) * DM + col0 + bj * HALF);
            rss_t qraw[4];
#pragma unroll
            for (int m = 0; m < 4; ++m) { sc2[m] = cscale; qs[m] = 0.f; if constexpr (X8OUT) qraw[m] = rss_q[row0 + ai * HALF + m * 16]; }
            if constexpr (X8OUT) { __builtin_amdgcn_sched_barrier(0);
#pragma unroll
                for (int m = 0; m < 4; ++m) qs[m] = QC * rstd_raw(qraw[m]); }
#pragma unroll
            for (int m = 0; m < 4; ++m) { const int r = row0 + ai * HALF + m * 16; const size_t off = (size_t)r * DM + col0; float ss = 0.f;
#pragma unroll
                for (int bj = 0; bj < 2; ++bj) { float hv[8]; const pg8::u32x4 w0 = hw[m][bj];
#pragma unroll
                    for (int e = 0; e < 4; ++e) { hv[2 * e] = bflo(w0[e]); hv[2 * e + 1] = bfhi(w0[e]); }
#pragma unroll
                    for (int e = 0; e < 4; ++e) {
                        if constexpr (ACCI) { const pg8::f32x4 a0 = acc[ai][bj][m][0], a1 = acc[ai][bj][m][1]; const float x0 = a0[e], x1 = a1[e];
                            hv[e] += (float)(__float_as_int(x0) + zc[bj][e]) * ics; hv[4 + e] += (float)(__float_as_int(x1) + zc[bj][4 + e]) * ics; }
                        else { hv[e] += acc[ai][bj][m][0][e] * sc2[m]; hv[4 + e] += acc[ai][bj][m][1][e] * sc2[m]; } }
                    pg8::u32x4 w; w.x = cvt_pk_bf16(hv[0], hv[1]); w.y = cvt_pk_bf16(hv[2], hv[3]); w.z = cvt_pk_bf16(hv[4], hv[5]); w.w = cvt_pk_bf16(hv[6], hv[7]);
                    *(pg8::u32x4*)(HB + off + bj * HALF) = w;
                    if constexpr (X8OUT) *(v2u*)(X8 + off + bj * HALF) = (v2u){pk4_i8(hv[0] * qs[m], hv[1] * qs[m], hv[2] * qs[m], hv[3] * qs[m]), pk4_i8(hv[4] * qs[m], hv[5] * qs[m], hv[6] * qs[m], hv[7] * qs[m])};
#pragma unroll
                    for (int e = 0; e < 4; ++e) { const float a = bflo(w[e]), b = bfhi(w[e]); ss += a * a + b * b; } }
                ssv[ai][m] = ss; }
            asm volatile("" ::: "memory");
        }
#pragma unroll
        for (int ai = 0; ai < 2; ++ai)
#pragma unroll
            for (int m = 0; m < 4; ++m) { float ss = ssv[ai][m]; ss += __shfl_xor(ss, 16); ss += __shfl_xor(ss, 32);
                if (fq == 0) atomicAdd(rss_out + row0 + ai * HALF + m * 16, (rss_t)(ss * RSS_SCALE)); }
    }
};

typedef EpiResT<false> EpiRes; typedef EpiResT<true> EpiResX8; typedef EpiResT<true, true> EpiResI; typedef EpiResT<false, true> EpiResIL;

__device__ __forceinline__ float wave_sum(float v) {
#pragma unroll
    for (int o = 1; o < 64; o <<= 1) v += __shfl_xor(v, o);
    return v;
}
__device__ __forceinline__ float wave_max(float v) {
#pragma unroll
    for (int o = 1; o < 64; o <<= 1) v = fmaxf(v, __shfl_xor(v, o));
    return v;
}
__device__ __forceinline__ void conv_item(const float* __restrict__ W, int ldw, int c0, int cvalid, const float* __restrict__ g, float gs, bf16* __restrict__ WT, int ldt, int drow0, int dcol0, int nblk, int item, int lane) {
    const int kb = item / nblk, nb = item % nblk, c = lane & 7, n4 = lane >> 3, k0 = 128 * kb + 8 * c, cs = c0 + 32 * nb + 4 * n4;
    f32x4 v[2][8];
#pragma unroll
    for (int hh = 0; hh < 2; ++hh)
#pragma unroll
        for (int i = 0; i < 8; ++i) { v[hh][i] = (f32x4){0.f, 0.f, 0.f, 0.f}; if (cs < cvalid) v[hh][i] = *(const f32x4*)(W + (size_t)(k0 + 64 * hh + i) * ldw + cs); }
#pragma unroll
    for (int hh = 0; hh < 2; ++hh) {
        if (g) {
            const f32x4 g0 = *(const f32x4*)(g + k0 + 64 * hh), g1 = *(const f32x4*)(g + k0 + 64 * hh + 4);
#pragma unroll
            for (int i = 0; i < 4; ++i) { v[hh][i] = v[hh][i] * (g0[i] * gs); v[hh][4 + i] = v[hh][4 + i] * (g1[i] * gs); }
        }
#pragma unroll
        for (int e = 0; e < 4; ++e) {
            v4u o; o.x = pk2(v[hh][0][e], v[hh][1][e]); o.y = pk2(v[hh][2][e], v[hh][3][e]); o.z = pk2(v[hh][4][e], v[hh][5][e]); o.w = pk2(v[hh][6][e], v[hh][7][e]);
            *(v4u*)(WT + (size_t)(drow0 + 32 * nb + 4 * n4 + e) * ldt + dcol0 + k0 + 64 * hh) = o; }
    }
}

__device__ __forceinline__ void conv_item_f8(const float* __restrict__ W, int ldw, const float* __restrict__ g, unsigned char* __restrict__ WT, int ldt, float scale, int nblk, int item, int lane) {
    const int kb = item / nblk, nb = item % nblk, c = lane & 7, n4 = lane >> 3, k0 = 128 * kb + 16 * c, cs = 32 * nb + 4 * n4;
    f32x4 v[16];
#pragma unroll
    for (int i = 0; i < 16; ++i) v[i] = *(const f32x4*)(W + (size_t)(k0 + i) * ldw + cs) * (g ? g[k0 + i] * scale : scale);
#pragma unroll
    for (int e = 0; e < 4; ++e) {
        v4u o; o.x = pk4_fp8(v[0][e], v[1][e], v[2][e], v[3][e]); o.y = pk4_fp8(v[4][e], v[5][e], v[6][e], v[7][e]); o.z = pk4_fp8(v[8][e], v[9][e], v[10][e], v[11][e]); o.w = pk4_fp8(v[12][e], v[13][e], v[14][e], v[15][e]);
        *(v4u*)(WT + (size_t)(32 * nb + 4 * n4 + e) * ldt + k0) = o; }
}

__device__ __forceinline__ float sample_step(const float* __restrict__ Ws, int ldw, const float* __restrict__ g, int lane) {
    const int c = lane & 7, n4 = lane >> 3; float ss = 0.f;
#pragma unroll
    for (int i = 0; i < 16; ++i) { const f32x4 t = *(const f32x4*)(Ws + (size_t)(16 * c + i) * ldw + 4 * n4) * (g ? g[16 * c + i] : 1.0f); ss += (t[0] * t[0] + t[1] * t[1]) + (t[2] * t[2] + t[3] * t[3]); }
    ss = wave_sum(ss);
    return WCLIP * sqrtf(ss * (1.0f / 4096.0f)) * (1.0f / 127.0f);
}
__device__ __forceinline__ void conv_item_i8(const float* __restrict__ W, int ldw, const float* __restrict__ g, unsigned char* __restrict__ WT, int ldt, float step, int nblk, int item, int lane, int* __restrict__ colsum = nullptr,
                                             int c0 = 0, int cvalid = 1 << 30, int drow0 = 0) {
    const int kb = item / nblk, nb = item % nblk, c = lane & 7, n4 = lane >> 3, k0 = 128 * kb + 16 * c, cs = c0 + 32 * nb + 4 * n4;
    f32x4 v[16];
#pragma unroll
    for (int i = 0; i < 16; ++i) { v[i] = (f32x4){0.f, 0.f, 0.f, 0.f}; if (cs < cvalid) v[i] = *(const f32x4*)(W + (size_t)(k0 + i) * ldw + cs) * (g ? g[k0 + i] : 1.0f); }
    const float inv = 1.0f / step;
#pragma unroll
    for (int e = 0; e < 4; ++e) {
        v4u o; o.x = pk4_i8(v[0][e] * inv, v[1][e] * inv, v[2][e] * inv, v[3][e] * inv); o.y = pk4_i8(v[4][e] * inv, v[5][e] * inv, v[6][e] * inv, v[7][e] * inv);
        o.z = pk4_i8(v[8][e] * inv, v[9][e] * inv, v[10][e] * inv, v[11][e] * inv); o.w = pk4_i8(v[12][e] * inv, v[13][e] * inv, v[14][e] * inv, v[15][e] * inv);
        *(v4u*)(WT + (size_t)(drow0 + 32 * nb + 4 * n4 + e) * ldt + k0) = o;
        if (colsum) {
            float cs4 = 0.f;
#pragma unroll
            for (int i = 0; i < 16; ++i) cs4 += fminf(fmaxf(__builtin_rintf(v[i][e] * inv), -128.0f), 127.0f);
            cs4 += __shfl_xor(cs4, 1); cs4 += __shfl_xor(cs4, 2); cs4 += __shfl_xor(cs4, 4);
            if (c == 0) atomicAdd(colsum + 32 * nb + 4 * n4 + e, (int)cs4); } }
}

__device__ __forceinline__ int wave_sum_i32(int v) {
    v += __builtin_amdgcn_update_dpp(0, v, 0xB1, 0xF, 0xF, false);
    v += __builtin_amdgcn_update_dpp(0, v, 0x4E, 0xF, 0xF, false);
    v += __builtin_amdgcn_update_dpp(0, v, 0x141, 0xF, 0xF, false);
    v += __builtin_amdgcn_update_dpp(0, v, 0x140, 0xF, 0xF, false);
    return __builtin_amdgcn_readlane(v, 0) + __builtin_amdgcn_readlane(v, 16) + __builtin_amdgcn_readlane(v, 32) + __builtin_amdgcn_readlane(v, 48);
}
template <int NCH> __device__ __forceinline__ void wave_topk256(const LAS float* sc, bf16* out, int lane) {
    constexpr int NK = 4 * NCH;
    unsigned key[NK];
#pragma unroll
    for (int r = 0; r < NCH; ++r) {
        f32x4 v = (f32x4){0.f, 0.f, 0.f, 0.f}; const bool have = true;
        v = *(const LAS f32x4*)(sc + 256 * r + 4 * lane);
#pragma unroll
        for (int e = 0; e < 4; ++e) { const float fe = v[e]; const unsigned uu = __float_as_uint(fe);
            const unsigned k = (uu & 0x80000000u) ? ~uu : (uu | 0x80000000u); key[4 * r + e] = have ? k : 0u; }
    }
    unsigned T = 0u; bool exact = false;
#pragma unroll 1
    for (int bit = 31; bit >= 0; --bit) {
        const unsigned cand = T | (1u << bit); int c = 0;
#pragma unroll
        for (int i = 0; i < NK; ++i) c += (key[i] >= cand) ? 1 : 0;
        const int cnt = wave_sum_i32(c);
        if (cnt >= TOPK) { T = cand; if (cnt == TOPK) { exact = true; break; } }
    }
    int need = 0;
    if (exact) T -= 1u;
    else { int c = 0;
#pragma unroll
        for (int i = 0; i < NK; ++i) c += (key[i] > T) ? 1 : 0;
        need = TOPK - wave_sum_i32(c); }
    int pos = 0;
    if (need == 0) {
#pragma unroll
        for (int i = 0; i < NK; ++i) {
            const bool sel = key[i] > T; const unsigned long long ms = __ballot(sel);
            const int p = pos + (int)__builtin_amdgcn_mbcnt_hi((unsigned)(ms >> 32), __builtin_amdgcn_mbcnt_lo((unsigned)ms, 0u));
            if (sel && p < TOPK) out[p] = (bf16)(256 * (i >> 2) + 4 * lane + (i & 3));
            pos += __popcll(ms);
        }
    } else {
        int tk = 0;
#pragma unroll
        for (int i = 0; i < NK; ++i) {
            const bool gt = key[i] > T, eq = key[i] == T;
            const unsigned long long meq = __ballot(eq);
            const int eqrank = tk + (int)__builtin_amdgcn_mbcnt_hi((unsigned)(meq >> 32), __builtin_amdgcn_mbcnt_lo((unsigned)meq, 0u));
            const bool sel = gt || (eq && eqrank < need);
            const unsigned long long ms = __ballot(sel);
            const int p = pos + (int)__builtin_amdgcn_mbcnt_hi((unsigned)(ms >> 32), __builtin_amdgcn_mbcnt_lo((unsigned)ms, 0u));
            if (sel && p < TOPK) out[p] = (bf16)(256 * (i >> 2) + 4 * lane + (i & 3));
            pos += __popcll(ms); tk += __popcll(meq);
        }
    }
}

typedef short bf16x8_t __attribute__((ext_vector_type(8)));
typedef short s16x4_t __attribute__((ext_vector_type(4)));
typedef float f4_t __attribute__((ext_vector_type(4)));
__device__ __forceinline__ s16x4_t lds_tr16(unsigned addr) {
    typedef short v4i16_t __attribute__((ext_vector_type(4)));
    return __builtin_bit_cast(s16x4_t, __builtin_amdgcn_ds_read_tr16_b64_v4i16((LAS v4i16_t*)(uintptr_t)addr));
}
constexpr int KST = 528;
constexpr int ATT_WAVE_LDS = 32 * KST + 512;

__device__ __forceinline__ void attn_query(const bf16* __restrict__ CKVb, const bf16* IDXrow, bf16* QO  , int nsel, LAS unsigned char* wl, int lane) {
    const int j = lane & 15, g = lane >> 4;
    LAS bf16* ids = (LAS bf16*)(wl + 32 * KST);
    *(LAS v2u*)(ids + 4 * lane) = *(const v2u*)(IDXrow + 4 * lane);
    bf16x8_t Bq[8];
#pragma unroll
    for (int s = 0; s < 8; ++s) Bq[s] = *(const bf16x8_t*)(QO + j * 256 + 32 * s + 8 * g);
    f4_t O[16];
#pragma unroll
    for (int d = 0; d < 16; ++d) O[d] = (f4_t){0.f, 0.f, 0.f, 0.f};
    float mrun = -__builtin_inff(), lsum = 0.f;
    const int nch = (nsel + 31) >> 5;
    asm volatile("s_waitcnt lgkmcnt(0)" ::: "memory");
    const unsigned wl_addr = (unsigned)(uintptr_t)wl;
    const unsigned a_rd = wl_addr + j * KST + 16 * g;
    const unsigned a_tr = wl_addr + (4 * g + (j >> 2)) * KST + 8 * (j & 3);
    v4u v[16];
#pragma unroll
    for (int p = 0; p < 16; ++p) { const int key = (int)ids[2 * p + (lane >> 5)];
        v[p] = *(const v4u*)(CKVb + (size_t)key * KVL + (lane & 31) * 8); }
    for (int c = 0; c < nch; ++c) {
#pragma unroll
        for (int p = 0; p < 16; ++p) *(LAS v4u*)(wl + (2 * p + (lane >> 5)) * KST + (lane & 31) * 16) = v[p];
        if (c + 1 < nch) {
#pragma unroll
            for (int p = 0; p < 16; ++p) { const int key = (int)ids[32 * (c + 1) + 2 * p + (lane >> 5)];
                v[p] = *(const v4u*)(CKVb + (size_t)key * KVL + (lane & 31) * 8); }
        }
        asm volatile("s_waitcnt lgkmcnt(0)" ::: "memory");
        f4_t S0 = (f4_t){0.f, 0.f, 0.f, 0.f}, S1 = (f4_t){0.f, 0.f, 0.f, 0.f};
#pragma unroll
        for (int s0 = 0; s0 < 8; s0 += ATT_RB) {
            bf16x8_t A0[ATT_RB], A1[ATT_RB];
#pragma unroll
            for (int q = 0; q < ATT_RB; ++q) { A0[q] = *(const LAS bf16x8_t*)(uintptr_t)(a_rd + 64 * (s0 + q)); A1[q] = *(const LAS bf16x8_t*)(uintptr_t)(a_rd + 16 * KST + 64 * (s0 + q)); }
            __builtin_amdgcn_sched_barrier(0);
#pragma unroll
            for (int q = 0; q < ATT_RB; ++q) { S0 = __builtin_amdgcn_mfma_f32_16x16x32_bf16(A0[q], Bq[s0 + q], S0, 0, 0, 0); S1 = __builtin_amdgcn_mfma_f32_16x16x32_bf16(A1[q], Bq[s0 + q], S1, 0, 0, 0); }
            __builtin_amdgcn_sched_barrier(0);
        }
        if (c == nch - 1) { const int kb = 32 * c + 4 * g;
#pragma unroll
            for (int i = 0; i < 4; ++i) { if (kb + i >= nsel) S0[i] = -__builtin_inff(); if (kb + 16 + i >= nsel) S1[i] = -__builtin_inff(); } }
        float mx = fmaxf(fmaxf(fmaxf(S0[0], S0[1]), fmaxf(S0[2], S0[3])), fmaxf(fmaxf(S1[0], S1[1]), fmaxf(S1[2], S1[3])));
        mx = fmaxf(mx, __shfl_xor(mx, 16)); mx = fmaxf(mx, __shfl_xor(mx, 32));
        const float mnew = fmaxf(mrun, mx), mrun0 = mrun;
        const float alpha = exp2f(mrun - mnew);
        float ps = 0.f; float p0[4], p1[4];
#pragma unroll
        for (int i = 0; i < 4; ++i) { p0[i] = exp2f(S0[i] - mnew); p1[i] = exp2f(S1[i] - mnew); ps += p0[i] + p1[i]; }
        lsum = lsum * alpha + ps; mrun = mnew;
        if (__any(mnew > mrun0)) {
#pragma unroll
            for (int d = 0; d < 16; ++d) O[d] = O[d] * alpha; }
        bf16x8_t Bp; { const unsigned w0 = pg8::cvt_pk_bf16(p0[0], p0[1]), w1 = pg8::cvt_pk_bf16(p0[2], p0[3]), w2 = pg8::cvt_pk_bf16(p1[0], p1[1]), w3 = pg8::cvt_pk_bf16(p1[2], p1[3]);
            Bp = __builtin_bit_cast(bf16x8_t, (v4u){w0, w1, w2, w3}); }
#pragma unroll
        for (int d0 = 0; d0 < 16; d0 += ATT_PB) {
            s16x4_t lo[ATT_PB], hi[ATT_PB];
#pragma unroll
            for (int q = 0; q < ATT_PB; ++q) { lo[q] = lds_tr16(a_tr + 32 * (d0 + q)); hi[q] = lds_tr16(a_tr + 16 * KST + 32 * (d0 + q)); }
            __builtin_amdgcn_sched_barrier(0);
#pragma unroll
            for (int q = 0; q < ATT_PB; ++q) { const bf16x8_t A = (bf16x8_t){lo[q][0], lo[q][1], lo[q][2], lo[q][3], hi[q][0], hi[q][1], hi[q][2], hi[q][3]};
                O[d0 + q] = __builtin_amdgcn_mfma_f32_16x16x32_bf16(A, Bp, O[d0 + q], 0, 0, 0); }
            __builtin_amdgcn_sched_barrier(0);
        }
        asm volatile("s_waitcnt lgkmcnt(0)" ::: "memory");
    }
    lsum += __shfl_xor(lsum, 16); lsum += __shfl_xor(lsum, 32);
    const float inv = 1.0f / lsum;
#pragma unroll
    for (int d = 0; d < 16; ++d) { const f4_t o = O[d] * inv; *(v2u*)(QO + j * 256 + 16 * d + 4 * g) = (v2u){pg8::cvt_pk_bf16(o[0], o[1]), pg8::cvt_pk_bf16(o[2], o[3])}; }
}

constexpr int SCST = 2192;
static_assert(2 * SCST * 4 >= ATT_WAVE_LDS && 16 * SCST * 4 + 1024 <= LDS_PHASE_BYTES, "indexer / attention LDS map");
__device__ __forceinline__ void index_unit(const bf16* __restrict__ QIDX, const bf16* __restrict__ KIDXb, const float* __restrict__ WIDX, bf16* IDX, const bf16* __restrict__ CKVb, bf16* QLAT, int b, int qt, LAS unsigned char* lds, int wave_s) {
    const int tid = fresh_tid(wave_s);
    const int lane = tid & 63, wave = __builtin_amdgcn_readfirstlane(tid >> 6);
    const int row0 = b * SEQ + 16 * qt;
    if (qt < 16) {
        const int e8 = tid * 8, k = e8 & 255;
        const unsigned k0 = (unsigned)k | ((unsigned)(k + 1) << 16), k1 = (unsigned)(k + 2) | ((unsigned)(k + 3) << 16), k2 = (unsigned)(k + 4) | ((unsigned)(k + 5) << 16), k3 = (unsigned)(k + 6) | ((unsigned)(k + 7) << 16);
        *(v4u*)(IDX + (size_t)row0 * TOPK + e8) = (v4u){k0, k1, k2, k3};
        __syncthreads();
#pragma unroll 1
        for (int qq = 0; qq < 2; ++qq) { const int row = row0 + 2 * wave + qq, t = row & (SEQ - 1);
            attn_query(CKVb, IDX + (size_t)row * TOPK, QLAT + (size_t)row * 4096, (t + 1 < TOPK) ? t + 1 : TOPK, lds + wave * (2 * SCST * 4), lane); }
        __syncthreads();
        return;
    }
    LAS float* sc = (LAS float*)lds;
    const int j = lane & 15, g = lane >> 4;
    constexpr int QST = 2048 + 16;
#pragma unroll
    for (int i = 0; i < 4; ++i) { const int pc = tid + NTHR * i, rw = pc >> 7, c16 = pc & 127;
        *(LAS v4u*)(lds + rw * QST + c16 * 16) = *(const v4u*)(QIDX + (size_t)(row0 + rw) * 1024 + c16 * 8); }
    LAS float* wl = (LAS float*)(lds + 16 * SCST * 4);
    if (tid < 256) wl[tid] = WIDX[(size_t)row0 * IDXH + tid];
    __syncthreads();
    bf16x8_t Bq[16][2];
#pragma unroll
    for (int h = 0; h < 16; ++h)
#pragma unroll
        for (int s2 = 0; s2 < 2; ++s2) Bq[h][s2] = *(const LAS bf16x8_t*)(lds + j * QST + h * 128 + s2 * 64 + g * 16);
    __syncthreads();
    const LAS float* wq = wl + j * IDXH;
    const int nT = qt + 1, nTpad = ((nT + 15) >> 4) << 4;
    const float ninf = -__builtin_inff();
    const bf16x8_t zf = (bf16x8_t){0, 0, 0, 0, 0, 0, 0, 0};
    bf16x8_t Pa0 = zf, Pa1 = zf, Pb0 = zf, Pb1 = zf, Pc0 = zf, Pc1 = zf;
    { const bf16* kp = KIDXb + (size_t)j * IDXD + 8 * g;
      if (wave < nT) { Pa0 = *(const bf16x8_t*)(kp + (size_t)(16 * wave) * IDXD); Pa1 = *(const bf16x8_t*)(kp + (size_t)(16 * wave) * IDXD + 32); }
      if (wave + NWAVES < nT) { Pb0 = *(const bf16x8_t*)(kp + (size_t)(16 * (wave + NWAVES)) * IDXD); Pb1 = *(const bf16x8_t*)(kp + (size_t)(16 * (wave + NWAVES)) * IDXD + 32); }
      if (wave + 2 * NWAVES < nT) { Pc0 = *(const bf16x8_t*)(kp + (size_t)(16 * (wave + 2 * NWAVES)) * IDXD); Pc1 = *(const bf16x8_t*)(kp + (size_t)(16 * (wave + 2 * NWAVES)) * IDXD + 32); } }
    for (int T = wave; T < nTpad; T += NWAVES) {
        f4_t score = (f4_t){ninf, ninf, ninf, ninf};
        const bf16x8_t A0 = Pa0, A1 = Pa1;
        Pa0 = Pb0; Pa1 = Pb1; Pb0 = Pc0; Pb1 = Pc1;
        if (T + 3 * NWAVES < nT) { const bf16* kp = KIDXb + (size_t)(16 * (T + 3 * NWAVES) + j) * IDXD + 8 * g; Pc0 = *(const bf16x8_t*)kp; Pc1 = *(const bf16x8_t*)(kp + 32); }
        if (T < nT) {
            score = (f4_t){0.f, 0.f, 0.f, 0.f};
#pragma unroll
            for (int h = 0; h < 16; ++h) {
                f4_t D = __builtin_amdgcn_mfma_f32_16x16x32_bf16(A0, Bq[h][0], (f4_t){0.f, 0.f, 0.f, 0.f}, 0, 0, 0);
                D = __builtin_amdgcn_mfma_f32_16x16x32_bf16(A1, Bq[h][1], D, 0, 0, 0);
                { const float wh = wq[h];
#pragma unroll
                for (int i = 0; i < 4; ++i) score[i] += wh * __builtin_amdgcn_fmed3f(D[i], 0.f, __builtin_inff()); }
                if ((h & 3) == 3) __builtin_amdgcn_sched_barrier(0);
            }
            if (T == qt) {
#pragma unroll
                for (int i = 0; i < 4; ++i) if (4 * g + i > j) score[i] = ninf;
            }
        }
        *(LAS f4_t*)(sc + j * SCST + 16 * T + 4 * g) = score;
    }
    __syncthreads();
#pragma unroll 1
    for (int qq = 0; qq < 2; ++qq) { const int q = 2 * wave + qq; const LAS float* sq = sc + q * SCST; bf16* oq = IDX + (size_t)(row0 + q) * TOPK;
        switch (qt >> 4) {
            case 1: wave_topk256<2>(sq, oq, lane); break; case 2: wave_topk256<3>(sq, oq, lane); break; case 3: wave_topk256<4>(sq, oq, lane); break;
            case 4: wave_topk256<5>(sq, oq, lane); break; case 5: wave_topk256<6>(sq, oq, lane); break; case 6: wave_topk256<7>(sq, oq, lane); break;
            default: wave_topk256<8>(sq, oq, lane); break; } }
    asm volatile("s_waitcnt vmcnt(0)" ::: "memory");
#pragma unroll 1
    for (int qq = 0; qq < 2; ++qq) { const int row = row0 + 2 * wave + qq;
        attn_query(CKVb, IDX + (size_t)row * TOPK, QLAT + (size_t)row * 4096, TOPK, lds + wave * (2 * SCST * 4), lane); }
    __syncthreads();
}

struct Args { const float* in[19]; float* out; unsigned char* ws; int ph_lo, ph_hi; };
constexpr int PH_PRO = 0, PH_PER_PAIR = 15, PH_FINAL = 1 + 2 * PH_PER_PAIR, N_PHASES = PH_FINAL + 1;

__global__ void __launch_bounds__(NTHR, 2) fwd(Args args) {
    extern __shared__ __attribute__((aligned(16))) unsigned char lds_raw[];
    LAS unsigned char* lds = (LAS unsigned char*)lds_raw;
    const int tid0 = threadIdx.x; const int wave_s = __builtin_amdgcn_readfirstlane(tid0 >> 6);
#define PHASE_IDS const int tid = fresh_tid(wave_s); const int lane = tid & 63, wave = wave_s; const int gw = blockIdx.x * NWAVES + wave, NGW = G * NWAVES; (void)lane; (void)gw; (void)NGW
    const int G = gridDim.x;
    unsigned char* ws = args.ws;
    gu32* ctl = (gu32*)(ws + WS_CTL);
    const int lo = args.ph_lo, hi = args.ph_hi;
    const float* x = args.in[0]; const float* norm_mix = args.in[1]; const float* norm_mlp = args.in[2]; const float* mlp_w1 = args.in[3]; const float* mlp_w2 = args.in[4];
    const float* conv_in = args.in[5]; const float* conv_w = args.in[6]; const float* conv_out = args.in[7]; const float* attn_in = args.in[8];
    const float* q_norm = args.in[9]; const float* kv_norm = args.in[10]; const float* w_uq = args.in[11]; const float* w_uk = args.in[12]; const float* w_uv = args.in[13];
    const float* w_qidx = args.in[14]; const float* ln_g = args.in[15]; const float* ln_b = args.in[16]; const float* attn_out = args.in[17]; const float* final_norm = args.in[18];
    bf16* HB = (bf16*)(ws + WS_HB);
    rss_t* RSS = (rss_t*)(ws + WS_RSS);
    float* SBW = (float*)(ws + WS_SBW);
    float* RFV = (float*)(ws + WS_SBW + 65536);
    int* COLSUM = (int*)(ws + WS_SBW + 4096);

    LAS unsigned* MISC = (LAS unsigned*)(lds + LDSCTL_OFF);
    for (int u = tid0; u < (LDS_BYTES - LDSCTL_OFF) / 4; u += NTHR) MISC[u] = 0u;
    __syncthreads();
    XcdBarrier bar; bar.bar = (unsigned*)(ctl + CW_BAR); bar.x = 0; bar.st = nullptr; bar.wave_s = wave_s;
    if (MK_ONE_LAUNCH) bar = xcd_barrier_post((unsigned*)(ctl + CW_BAR), (volatile LAS unsigned*)(MISC + 8), wave_s);
#define IN(k) (lo <= (k) && (k) < hi)
#define SEAM(k) do { if (IN(k) && IN((k) + 1)) xcd_barrier(bar); } while (0)
#define SEAM_G(k) do { if (IN(k) && IN((k) + 1)) { if (GROUP_SEAMS) { if (MISC[16]) grp_barrier_fast((unsigned*)(ctl + CW_BAR), bar.x, wave_s); else grp_barrier((unsigned*)(ctl + CW_BAR), (int)(blockIdx.x & 7), wave_s); } else xcd_barrier(bar); } } while (0)

    if (IN(PH_PRO)) {
        PHASE_IDS;
        {
        LAS float* stepL = (LAS float*)lds;
        for (int sl = wave; sl < 18; sl += NWAVES) {
            int lane_l = lane; asm volatile("" : "+v"(lane_l)); const int lane = lane_l;
            float st = 0.f; const int j = sl & 1;
            if (sl < 4) st = sample_step(mlp_w1 + (size_t)sl * DM * FF, FF, norm_mlp + (size_t)sl * DM, lane);
            else if (sl < 8) st = sample_step(mlp_w2 + (size_t)(sl - 4) * FF * DM, DM, nullptr, lane);
            else if (sl < 10) { if (j >= I8_CONV_FROM) st = sample_step(conv_in + (size_t)j * DM * 3 * DM + DM, 3 * DM, norm_mix + (size_t)(2 * j) * DM, lane); }
            else if (sl < 12) { if (j >= I8_CONV_FROM) st = sample_step(conv_in + (size_t)j * DM * 3 * DM, 3 * DM, norm_mix + (size_t)(2 * j) * DM, lane); }
            else if (sl < 14) st = sample_step(attn_in + (size_t)j * DM * INC, INC, norm_mix + (size_t)(2 * j + 1) * DM, lane);
            else if (sl < 16) {
                const float* uq0 = w_uq + (size_t)j * QLORA * 2048; const float* uk0 = w_uk + (size_t)j * NHEAD * 128 * KVL + lane; const float* gq0 = q_norm + (size_t)j * QLORA;
                float a0[4] = {0.f, 0.f, 0.f, 0.f};
                for (int d = 0; d < 128; ++d) { const float bv = uk0[(size_t)d * KVL];
#pragma unroll
                    for (int i = 0; i < 4; ++i) a0[i] += uq0[(size_t)i * 2048 + d] * bv; }
                float ss = 0.f;
#pragma unroll
                for (int i = 0; i < 4; ++i) { const float t = a0[i] * gq0[i] * QSCALE; ss += t * t; }
                ss = wave_sum(ss); st = WCLIP * sqrtf(ss * (1.0f / 256.0f)) * (1.0f / 127.0f); }
            else st = sample_step(w_qidx + (size_t)j * QLORA * 1024, 1024, q_norm + (size_t)j * QLORA, lane);
            if (lane == 0) { stepL[sl] = st; if (blockIdx.x == 0) SBW[sl] = st; }
        }
        __syncthreads();
        constexpr int I_CA = (DM / 128) * (4096 / 32), I_CB = (DM / 128) * (DM / 32), I_CO = I_CB;
        constexpr int I_W1 = (DM / 128) * (FF / 32), I_W2 = (FF / 128) * (DM / 32);
        constexpr int I_AI = (DM / 128) * (INCP / 32), I_QI = (QLORA / 128) * (1024 / 32), I_UV = 16 * (KVL / 128) * (128 / 32), I_AO = I_CB;
        constexpr int PER_CONV = I_CA + I_CB + I_CO, PER_MLP = I_W1 + I_W2, PER_ATT = I_AI + I_QI + I_UV + I_AO;
        constexpr int NITEMS = 2 * PER_CONV + 4 * PER_MLP + 2 * PER_ATT;
#pragma unroll 1
        for (int pass = 0; pass < 2; ++pass) {
        const bool do_b = (((int)blockIdx.x & 1) != 0) == (pass == 0);
        if (!do_b) {
        for (int it = gw; it < NITEMS; it += NGW) {
            int lane_l = lane; asm volatile("" : "+v"(lane_l)); const int lane = lane_l;
            int r = it;
            if (r < 2 * PER_CONV) { const int j = r / PER_CONV; r -= j * PER_CONV;
                const float* Wi = conv_in + (size_t)j * DM * 3 * DM; const float* gn = norm_mix + (size_t)(2 * j) * DM;
                if (r < I_CA) {
                    const int nb = r % 128, kb = r / 128, pn = nb >> 3, which = (nb >> 2) & 1, i0 = (nb & 3) * 32;
                    if (j >= I8_CONV_FROM) conv_item_i8(Wi, 3 * DM, gn, (unsigned char*)(ws + WS_WCA + j * CONV_W_STRIDE), DM, stepL[8 + j], 1, kb, lane, nullptr, DM * (1 + which) + 128 * pn + i0, 3 * DM, 32 * nb);
                    else conv_item(Wi, 3 * DM, DM * (1 + which) + 128 * pn + i0, 3 * DM, gn, 1.f, (bf16*)(ws + WS_WCA + j * CONV_W_STRIDE), DM, 32 * nb, 0, 1, kb, lane);
                    continue; }
                r -= I_CA;
                if (r < I_CB) {
                    if (j >= I8_CONV_FROM) conv_item_i8(Wi, 3 * DM, gn, (unsigned char*)(ws + WS_WCB + j * CONV_W_STRIDE), DM, stepL[10 + j], DM / 32, r, lane);
                    else conv_item(Wi, 3 * DM, 0, DM, gn, 1.f, (bf16*)(ws + WS_WCB + j * CONV_W_STRIDE), DM, 0, 0, DM / 32, r, lane);
                    continue; }
                r -= I_CB;
                conv_item(conv_out + (size_t)j * DM * DM, DM, 0, DM, nullptr, 1.f, (bf16*)(ws + WS_WCO + j * CONV_W_STRIDE), DM, 0, 0, DM / 32, r, lane); continue; }
            r -= 2 * PER_CONV;
            if (r < 4 * PER_MLP) { const int i = r / PER_MLP; r -= i * PER_MLP;
                if (r < I_W1) {
                    conv_item_i8(mlp_w1 + (size_t)i * DM * FF, FF, norm_mlp + (size_t)i * DM, (unsigned char*)(ws + WS_W1 + i * W1_STRIDE), DM, stepL[i], FF / 32, r, lane);
                    continue; }
                r -= I_W1;
                conv_item_i8(mlp_w2 + (size_t)i * FF * DM, DM, nullptr, (unsigned char*)(ws + WS_W2 + i * W2_STRIDE), FF, stepL[4 + i], DM / 32, r, lane, COLSUM + i * DM);
                continue; }
            r -= 4 * PER_MLP;
            { const int j = r / PER_ATT; r -= j * PER_ATT;
                if (r < I_AI) { conv_item_i8(attn_in + (size_t)j * DM * INC, INC, norm_mix + (size_t)(2 * j + 1) * DM, (unsigned char*)(ws + WS_WAI + j * ATT_W_STRIDE), DM, stepL[12 + j], INCP / 32, r, lane, nullptr, 0, INC); continue; }
                r -= I_AI;
                if (r < I_QI) { conv_item_i8(w_qidx + (size_t)j * QLORA * 1024, 1024, q_norm + (size_t)j * QLORA, (unsigned char*)(ws + WS_WQ + j * ATT_W_STRIDE), QLORA, stepL[16 + j], 1024 / 32, r, lane, nullptr, 0, 1 << 30, 4096); continue; }
                r -= I_QI;
                if (r < I_UV) {
                    const int h = r / 8, rr = r % 8;
                    conv_item(w_uv + (size_t)j * NHEAD * KVL * 128 + (size_t)h * KVL * 128, 128, 0, 128, nullptr, 1.f, (bf16*)(ws + WS_WUV + j * ATT_W_STRIDE), 512, h * 128, (h & 1) * 256, 4, rr, lane); continue; }
                r -= I_UV;
                if (FP8_AO) conv_item_f8(attn_out + (size_t)j * DM * DM, DM, nullptr, (unsigned char*)(ws + WS_WAO + j * ATT_W_STRIDE), DM, 64.0f, DM / 32, r, lane);
                else conv_item(attn_out + (size_t)j * DM * DM, DM, 0, DM, nullptr, 1.f, (bf16*)(ws + WS_WAO + j * ATT_W_STRIDE), DM, 0, 0, DM / 32, r, lane); }
        }
        for (int it = gw; it < 2 * 2048; it += NGW) { const int j = it >> 11, n = it & 2047, h = n >> 7;
            bf16* p = (bf16*)(ws + WS_WUV + j * ATT_W_STRIDE) + (size_t)n * 512 + (1 - (h & 1)) * 256;
            *(v2u*)(p + 4 * lane) = (v2u){0u, 0u}; }
        } else {
        for (int it = gw; it < 2 * 16 * 32 * 4; it += NGW) {
            const int cb = it & 3, rb = (it >> 2) & 31, h = (it >> 7) & 15, j = it >> 11;
            const float* uq = w_uq + (size_t)j * QLORA * 2048 + (size_t)(rb * 16) * 2048 + h * 128;
            const float* uk = w_uk + (size_t)j * NHEAD * 128 * KVL + (size_t)h * 128 * KVL + cb * 64 + lane;
            float a[16];
#pragma unroll
            for (int i = 0; i < 16; ++i) a[i] = 0.f;
            LAS float* aL = (LAS float*)(lds + 1024 + wave * 8192);
#pragma unroll
            for (int q = 0; q < 8; ++q) { const int f = 4 * (lane + 64 * q); *(LAS f32x4*)(aL + f) = *(const f32x4*)(uq + (size_t)(f >> 7) * 2048 + (f & 127)); }
#pragma unroll 2
            for (int d = 0; d < 128; d += 8) { float bv[8];
#pragma unroll
                for (int t = 0; t < 8; ++t) bv[t] = uk[(size_t)(d + t) * KVL];
#pragma unroll
                for (int i = 0; i < 16; ++i) { const f32x4 a0 = *(const LAS f32x4*)(aL + i * 128 + d), a1 = *(const LAS f32x4*)(aL + i * 128 + d + 4);
                    a[i] += (a0[0] * bv[0] + a0[1] * bv[1]) + (a0[2] * bv[2] + a0[3] * bv[3]) + (a1[0] * bv[4] + a1[1] * bv[5]) + (a1[2] * bv[6] + a1[3] * bv[7]); } }
            const float* gq = q_norm + (size_t)j * QLORA + rb * 16;
            const float inv = 1.0f / stepL[14 + j];
            float q[16];
#pragma unroll
            for (int i = 0; i < 16; ++i) q[i] = a[i] * gq[i] * QSCALE * inv;
            unsigned char* dst = (unsigned char*)(ws + WS_WQ + j * ATT_W_STRIDE) + (size_t)(h * 256 + cb * 64 + lane) * QLORA + rb * 16;
            *(v4u*)dst = (v4u){pk4_i8(q[0], q[1], q[2], q[3]), pk4_i8(q[4], q[5], q[6], q[7]), pk4_i8(q[8], q[9], q[10], q[11]), pk4_i8(q[12], q[13], q[14], q[15])};
        }
        } }
        for (int m = gw; m < M; m += NGW) {
            const f32x4* xr = (const f32x4*)(x + (size_t)m * DM) + lane; float s = 0.f; f32x4 v[8];
#pragma unroll
            for (int j = 0; j < 8; ++j) { v[j] = xr[64 * j]; s += (v[j][0] * v[j][0] + v[j][1] * v[j][1]) + (v[j][2] * v[j][2] + v[j][3] * v[j][3]); }
            s = wave_sum(s);
            v2u* o8 = (v2u*)(HB + (size_t)m * DM) + lane;
#pragma unroll
            for (int j = 0; j < 8; ++j) o8[64 * j] = (v2u){pk2(v[j][0], v[j][1]), pk2(v[j][2], v[j][3])};
            if (lane == 0) RSS[m] = (rss_t)(s * RSS_SCALE);
        }
        }
    }
    if (GROUP_SEAMS && MK_ONE_LAUNCH && IN(PH_PRO) && tid0 == 0) ((unsigned*)(ctl + CW_BAR))[XL_TAB + blockIdx.x] = bar.x + 1u;
    SEAM(PH_PRO);
    if (GROUP_SEAMS && MK_ONE_LAUNCH && IN(PH_PRO) && IN(PH_PRO + 1)) {
        if (wave_s == 0) { const int ln = fresh_tid(0); const unsigned mine = bar.x + 1u;
            const unsigned v = (ln < 32) ? xb_ld(&((unsigned*)(ctl + CW_BAR))[XL_TAB + 8 * ln + (blockIdx.x & 7)]) : mine;
            const bool ok = __all(v == mine) && (MISC[8] == 32u);
            if (ln == 0) MISC[16] = ok ? 1u : 0u; }
        __syncthreads();
    }

    for (int i = 0; i < DEPTH; ++i) {
        const int j = i >> 1;
        const int pb = 1 + j * PH_PER_PAIR + ((i & 1) ? 5 : 0);
        rss_t* rss_mix = RSS + (size_t)(2 * i) * M; rss_t* rss_mlp = RSS + (size_t)(2 * i + 1) * M; rss_t* rss_next = RSS + (size_t)(2 * i + 2) * M;
        int pm;
        if ((i & 1) == 0) {
            bf16* Z = (bf16*)(ws + WS_Z); bf16* U = (bf16*)(ws + WS_U);
            const rss_t* rss_pq = rss_mix - M;
            if (IN(pb + 0)) {
                pg8::StaticOrder S; S.init(M, 4096, G, (int)blockIdx.x);
                if (j >= I8_CONV_FROM) { pg8::Gemm g{(const bf16*)(ws + WS_X8), (const bf16*)(ws + WS_WCA + j * CONV_W_STRIDE), M, 4096, DM, DM, DM, 0}; EpiZI E{Z}; pg8::gemm_phase<EpiZI, pg8::StaticOrder, true, true, PG8_LAYOUT8, 1, true>(lds, g, S, E, wave_s); }
                else { pg8::Gemm g{HB, (const bf16*)(ws + WS_WCA + j * CONV_W_STRIDE), M, 4096, DM, DM, DM, 0}; EpiZ E{Z}; pg8::gemm_phase<EpiZ, pg8::StaticOrder, true, true>(lds, g, S, E, wave_s); }
                { const int tid = fresh_tid(wave_s);
                  if (tid < M / 256) { const int row = 4096 * (int)(blockIdx.x & 7) + (int)(blockIdx.x >> 3) * (M / 256) + tid;   RFV[row] = (j >= I8_CONV_FROM) ? rowf<true>(rss_mix, rss_pq, row) : rowf<false>(rss_mix, nullptr, row); } }
            }
            SEAM_G(pb + 0);
            if (IN(pb + 1)) {
                pg8::StaticOrder S; S.init(M, DM, G, (int)blockIdx.x);
                if (j >= I8_CONV_FROM) { pg8::Gemm g{(const bf16*)(ws + WS_X8), (const bf16*)(ws + WS_WCB + j * CONV_W_STRIDE), M, DM, DM, DM, DM, 0}; EpiUI E{U, Z, conv_w + (size_t)j * 3 * DM, RFV, SBW + 8 + j, SBW + 10 + j};
                    pg8::gemm_phase<EpiUI, pg8::StaticOrder, true, true, PG8_LAYOUT8, 1, true>(lds, g, S, E, wave_s); }
                else { pg8::Gemm g{HB, (const bf16*)(ws + WS_WCB + j * CONV_W_STRIDE), M, DM, DM, DM, DM, 0}; EpiU E{U, Z, conv_w + (size_t)j * 3 * DM, RFV};
                    pg8::gemm_phase<EpiU, pg8::StaticOrder, true, true>(lds, g, S, E, wave_s); }
            }
            SEAM_G(pb + 1);
            if (IN(pb + 2)) {
                pg8::Gemm g{U, (const bf16*)(ws + WS_WCO + j * CONV_W_STRIDE), M, DM, DM, DM, DM, 0}; pg8::StaticOrder S; S.init(M, DM, G, (int)blockIdx.x);
                EpiResX8 E{HB, rss_mlp, nullptr, 1.0f, ws + WS_X8, rss_mix}; pg8::gemm_phase<EpiResX8, pg8::StaticOrder, true, true>(lds, g, S, E, wave_s);
            }
            SEAM_G(pb + 2);
            pm = pb + 3;
        } else {
            float* PROJ = (float*)(ws + WS_PROJ); bf16* CQN = (bf16*)(ws + WS_CQN); bf16* CKV = (bf16*)(ws + WS_CKV); bf16* KIDX = (bf16*)(ws + WS_KIDX); float* WIDX = (float*)(ws + WS_WIDX);
            bf16* QLAT = (bf16*)(ws + WS_QLAT); bf16* QIDX = (bf16*)(ws + WS_QIDX); bf16* IDX = (bf16*)(ws + WS_IDX); bf16* O = (bf16*)(ws + WS_O);
            if (IN(pb + 0)) {
                pg8::Gemm g{(const bf16*)(ws + WS_X8), (const bf16*)(ws + WS_WAI + j * ATT_W_STRIDE), M, INCP, DM, DM, DM, 0}; pg8::StaticOrder S; S.init(M, INCP, G, (int)blockIdx.x);
                EpiProjI E{PROJ, INCP, rss_mix, rss_mix - M, SBW + 12 + j, (unsigned char*)CQN, RSS + (size_t)(9 + j) * M};
                pg8::gemm_phase<EpiProjI, pg8::StaticOrder, true, true, PG8_LAYOUT8, 1, true>(lds, g, S, E, wave_s);
            }
            SEAM_G(pb + 0);
            if (IN(pb + 2)) {
                {
                    PHASE_IDS;
                    const float* kvg = kv_norm + (size_t)j * KVL; const float* lg = ln_g + (size_t)j * IDXD; const float* lb = ln_b + (size_t)j * IDXD;
                    const f32x4 gk = *(const f32x4*)(kvg + 4 * lane); const float lgl = lg[lane], lbl = lb[lane];
                    const int gwl = (int)(blockIdx.x >> 3) * NWAVES + wave, rbase = 4096 * (int)(blockIdx.x & 7);
                    for (int m0 = rbase + gwl; m0 < rbase + 4096; m0 += 2 * 256) {
                        f32x4 kv[2]; float ki[2], wi[2];
#pragma unroll
                        for (int rr = 0; rr < 2; ++rr) { const float* pr = PROJ + (size_t)(m0 + rr * 256) * INCP;
                            kv[rr] = *(const f32x4*)(pr + 512 + 4 * lane); ki[rr] = pr[768 + lane]; wi[rr] = (lane < 16) ? pr[832 + lane] : 0.f; }
#pragma unroll
                        for (int rr = 0; rr < 2; ++rr) { const int m = m0 + rr * 256;
                            float sk = (kv[rr][0] * kv[rr][0] + kv[rr][1] * kv[rr][1]) + (kv[rr][2] * kv[rr][2] + kv[rr][3] * kv[rr][3]);
                            sk = wave_sum(sk);
                            const float rk = rsqrtf(sk * (1.0f / KVL) + EPS);
                            const float mu = wave_sum(ki[rr]) * (1.0f / IDXD); const float dk = ki[rr] - mu; const float var = wave_sum(dk * dk) * (1.0f / IDXD);
                            const float kn = dk * rsqrtf(var + EPS) * lgl + lbl;
                            *(v2u*)(CKV + (size_t)m * KVL + 4 * lane) = (v2u){pk2(kv[rr][0] * rk * gk[0], kv[rr][1] * rk * gk[1]), pk2(kv[rr][2] * rk * gk[2], kv[rr][3] * rk * gk[3])};
                            KIDX[(size_t)m * IDXD + lane] = (bf16)f2bf(kn);
                            if (lane < 16) WIDX[(size_t)m * IDXH + lane] = wi[rr] * 0.03125f; }
                    }
                }
                pg8::Gemm g{CQN, (const bf16*)(ws + WS_WQ + j * ATT_W_STRIDE), M, NQ, QLORA, QLORA, QLORA, 0}; pg8::StaticOrder S; S.init(M, NQ, G, (int)blockIdx.x);
                EpiBf16SI E{QLAT, 4096, QIDX, 1024, 4096, RSS + (size_t)(9 + j) * M, SBW + 14 + j, SBW + 16 + j};
                pg8::gemm_phase<EpiBf16SI, pg8::StaticOrder, true, true, PG8_LAYOUT8, 1, true>(lds, g, S, E, wave_s);
            }
            SEAM_G(pb + 2);
            if (IN(pb + 3)) {
                PHASE_IDS;
                const int grp = blockIdx.x & 7, r = blockIdx.x >> 3;
                for (int u = 0; u < 8; ++u) {
                    const int b = 2 * grp + ((u & 7) >> 2), v = u & 3, qt = (v == 0) ? r : (v == 1) ? 63 - r : (v == 2) ? 64 + r : 127 - r;
                    index_unit(QIDX, KIDX + (size_t)b * SEQ * IDXD, WIDX, IDX, CKV + (size_t)b * SEQ * KVL, QLAT, b, qt, lds, wave_s);
                }
            }
            SEAM_G(pb + 3);
#if 0
            if (IN(pb + 4)) {
                PHASE_IDS;
                const int grp = blockIdx.x & 7, rk = (blockIdx.x >> 3) * NWAVES + wave, nrk = (G >> 3) * NWAVES;
                LAS unsigned char* wl = lds + wave * ATT_WAVE_LDS;
                for (int q = rk; q < 2 * SEQ; q += nrk) {
                    const int row = (2 * grp) * SEQ + q, t = row & (SEQ - 1), b = row >> 11, nsel = (t + 1 < TOPK) ? t + 1 : TOPK;
                    attn_query(CKV + (size_t)b * SEQ * KVL, IDX + (size_t)row * TOPK, QLAT + (size_t)row * 4096, nsel, wl, lane);
                }
                __syncthreads();
            }
            SEAM(pb + 4);
#endif
            if (IN(pb + 5)) {
                pg8::Gemm g{QLAT, (const bf16*)(ws + WS_WUV + j * ATT_W_STRIDE), M, DM, 512, 4096, 512, 512}; pg8::StaticOrder S; S.init(M, DM, G, (int)blockIdx.x);
                if (FP8_AO) { EpiF8 E{(unsigned char*)O, DM, 8.0f}; pg8::gemm_phase<EpiF8, pg8::StaticOrder, true, true>(lds, g, S, E, wave_s); }
                else { EpiBf16 E{O, DM, O, DM, 1 << 30}; pg8::gemm_phase<EpiBf16, pg8::StaticOrder, true, true>(lds, g, S, E, wave_s); }
            }
            SEAM_G(pb + 5);
            if (IN(pb + 6)) {
                pg8::Gemm g{O, (const bf16*)(ws + WS_WAO + j * ATT_W_STRIDE), M, DM, DM, DM, DM, 0}; pg8::StaticOrder S; S.init(M, DM, G, (int)blockIdx.x);
                constexpr int AES = FP8_AO ? 1 : 2; const float cs = FP8_AO ? 1.0f / 512.0f : 1.0f;
                EpiResX8 E{HB, rss_mlp, nullptr, cs, ws + WS_X8, rss_mix}; pg8::gemm_phase<EpiResX8, pg8::StaticOrder, true, true, PG8_LAYOUT8, AES>(lds, g, S, E, wave_s);
            }
            SEAM_G(pb + 6);
            pm = pb + 8;
        }
        bf16* A1 = (bf16*)(ws + (GROUP_SEAMS ? ((i & 1) ? WS_QLAT : WS_BIG + 256 * MiB) : WS_A1));
        if (IN(pm)) {
            pg8::Gemm g{(const bf16*)(ws + WS_X8), (const bf16*)(ws + WS_W1 + i * W1_STRIDE), M, FF, DM, DM, DM, 0}; pg8::StaticOrder S; S.init(M, FF, G, (int)blockIdx.x);
            LAS unsigned char* rcache = lds + 131072 + wave_s * 2304;
            *(LAS int*)(rcache + 2048) = -1;
            EpiRelu2H8 E{(unsigned char*)A1, FF, rss_mlp, rss_mix, SBW + i, rcache};
            pg8::gemm_phase<EpiRelu2H8, pg8::StaticOrder, true, true, PG8_LAYOUT8, 1, true>(lds, g, S, E, wave_s);
        }
        SEAM_G(pm);
        if (IN(pm + 1)) {
            pg8::Gemm g{A1, (const bf16*)(ws + WS_W2 + i * W2_STRIDE), M, DM, FF, FF, FF, 0}; pg8::StaticOrder S; S.init(M, DM, G, (int)blockIdx.x);
            if (i + 1 < DEPTH) { EpiResI E{HB, rss_next, nullptr, 1.0f, ws + WS_X8, rss_mlp, nullptr, COLSUM + i * DM, SBW + 4 + i};
                pg8::gemm_phase<EpiResI, pg8::StaticOrder, true, true, PG8_LAYOUT8, 1, true>(lds, g, S, E, wave_s); }
            else { EpiResIL E{HB, rss_next, nullptr, 1.0f, nullptr, nullptr, nullptr, COLSUM + i * DM, SBW + 4 + i};
                pg8::gemm_phase<EpiResIL, pg8::StaticOrder, true, true, PG8_LAYOUT8, 1, true>(lds, g, S, E, wave_s); }
        }
        if (i + 1 < DEPTH) SEAM(pm + 1); else SEAM_G(pm + 1);
    }

    if (IN(PH_FINAL)) {
        PHASE_IDS;
        const rss_t* rss = RSS + (size_t)8 * M;
        const int gwl = (int)(blockIdx.x >> 3) * NWAVES + wave, rbase = GROUP_SEAMS ? 4096 * (int)(blockIdx.x & 7) : 0, rstep = GROUP_SEAMS ? 256 : NGW, r0 = GROUP_SEAMS ? gwl : gw, rend = GROUP_SEAMS ? 4096 : M;
        for (int m0 = rbase + r0; m0 < rbase + rend; m0 += 2 * rstep) {
            v4u hw[2][4]; float rs[2];
#pragma unroll
            for (int rr = 0; rr < 2; ++rr) { const int m = m0 + rr * rstep; rs[rr] = rstd_of(rss, m); const v4u* hr = (const v4u*)(HB + (size_t)m * DM) + lane;
#pragma unroll
                for (int jj = 0; jj < 4; ++jj) hw[rr][jj] = hr[64 * jj]; }
#pragma unroll
            for (int rr = 0; rr < 2; ++rr) { const int m = m0 + rr * rstep; f32x4* orow = (f32x4*)(args.out + (size_t)m * DM); const f32x4* gr = (const f32x4*)final_norm; const float r1 = rs[rr];
#pragma unroll
                for (int jj = 0; jj < 4; ++jj) { const v4u w4 = hw[rr][jj]; const int c = (64 * jj + lane) * 2; const f32x4 g0 = gr[c], g1 = gr[c + 1];
                    orow[c] = (f32x4){bflo(w4[0]) * r1 * g0[0], bfhi(w4[0]) * r1 * g0[1], bflo(w4[1]) * r1 * g0[2], bfhi(w4[1]) * r1 * g0[3]};
                    orow[c + 1] = (f32x4){bflo(w4[2]) * r1 * g1[0], bfhi(w4[2]) * r1 * g1[1], bflo(w4[3]) * r1 * g1[2], bfhi(w4[3]) * r1 * g1[3]}; } }
        }
    }
#undef IN
#undef SEAM
}

extern "C" void kernel_launch(void* const* d_in, const int* in_sizes, int n_in, void* d_out, int out_size, void* d_ws, size_t ws_size, hipStream_t stream) {
    static int grid = 0; static bool one_launch = false;
    if (grid == 0) {
        if (n_in != 19 || out_size != M * DM || ws_size < WS_END) { fprintf(stderr, "kernel_launch: unexpected shapes (n_in %d out %d ws %zu)\n", n_in, out_size, ws_size); grid = -1; return; }
        int dev = 0, cus = 0, per_cu = 0;
        if (hipGetDevice(&dev) != hipSuccess || hipDeviceGetAttribute(&cus, hipDeviceAttributeMultiprocessorCount, dev) != hipSuccess) { grid = -1; return; }
        if (hipFuncSetAttribute((const void*)fwd, hipFuncAttributeMaxDynamicSharedMemorySize, LDS_BYTES) != hipSuccess) { fprintf(stderr, "kernel_launch: hipFuncSetAttribute failed\n"); grid = -1; return; }
        if (hipOccupancyMaxActiveBlocksPerMultiprocessor(&per_cu, (const void*)fwd, NTHR, LDS_BYTES) != hipSuccess || per_cu < 1) fprintf(stderr, "kernel_launch: occupancy query says %d\n", per_cu);
        (void)hipGetLastError();
        grid = 256; one_launch = (MK_ONE_LAUNCH != 0) && (cus >= 256) && (per_cu >= 1);
    }
    if (grid < 0) return;
    if (hipMemsetAsync((char*)d_ws + WS_CTL, 0, CTL_ZERO_BYTES, stream) != hipSuccess) return;
    Args a{};
    for (int i = 0; i < 19; ++i) a.in[i] = (const float*)d_in[i];
    a.out = (float*)d_out; a.ws = (unsigned char*)d_ws;
    if (one_launch) {
        a.ph_lo = 0; a.ph_hi = N_PHASES;
        hipLaunchKernelGGL(fwd, dim3(grid), dim3(NTHR), LDS_BYTES, stream, a);
    } else {
        for (int p = 0; p < N_PHASES; ++p) {
            const int q = (p - 1) % PH_PER_PAIR;
            if (p >= 1 && p < PH_FINAL && (q == 12 || q == 6 || q == 9)) continue;
            a.ph_lo = p; a.ph_hi = p + 1;
            hipLaunchKernelGGL(fwd, dim3(grid), dim3(NTHR), LDS_BYTES, stream, a);
        }
    }
}
```

```cpp
#include <hip/hip_runtime.h>
#include <cstdio>
#include <cstdint>

#ifndef PG8_LAYOUT8
#define PG8_LAYOUT8 true
#endif
#ifndef ATT_RB
#define ATT_RB 4
#endif
#ifndef ATT_PB
#define ATT_PB 4
#endif
#ifndef GROUP_SEAMS
#define GROUP_SEAMS 1
#endif
#ifndef I8_CB_FROM
#define I8_CB_FROM 0
#endif
#ifndef F8_CO_FROM
#define F8_CO_FROM 1
#endif
#ifndef I8_CONV_FROM
#define I8_CONV_FROM 1
#endif
#ifndef FP8_AO
#define FP8_AO 1
#endif
#ifndef MK_ONE_LAUNCH
#define MK_ONE_LAUNCH 1
#endif

__device__ __forceinline__ int fresh_tid(int wave_s) { unsigned ones = 0xffffffffu; asm volatile("" : "+s"(ones)); return wave_s * 64 + (int)__builtin_amdgcn_mbcnt_hi(ones, __builtin_amdgcn_mbcnt_lo(ones, 0u)); }
namespace pg8 {
#define PG8_LAS __attribute__((address_space(3)))
typedef unsigned short bf16_t;
typedef short bf16x8 __attribute__((ext_vector_type(8)));
typedef float f32x4 __attribute__((ext_vector_type(4)));
typedef unsigned u32x4 __attribute__((ext_vector_type(4)));
typedef unsigned u32x2 __attribute__((ext_vector_type(2)));
typedef int v4i32 __attribute__((ext_vector_type(4)));
typedef int v8i32 __attribute__((ext_vector_type(8)));
constexpr int BM = 256, BK = 64, HALF = 128, HTB = HALF * BK * 2  , STAGE_BYTES = 8 * HTB, NXCD = 8, WGM = 8;

__host__ __device__ __forceinline__ int lds_byte(int r, int c) { const int st = (r >> 4) * 2 + (c >> 5), rr = r & 15, cc = c & 31, ob = rr * 64 + cc * 2; return st * 1024 + (ob ^ (((ob >> 9) & 1) << 5)); }
__host__ __device__ __forceinline__ void stage_rc(int b, int& R, int& C) { const int st = b / 1024, sb = b % 1024, swz = sb ^ (((sb >> 9) & 1) << 5); R = (st >> 1) * 16 + swz / 64; C = (st & 1) * 32 + (swz % 64) / 2; }
__host__ __device__ __forceinline__ int lds_byte8(int r, int c) { return (r >> 3) * 1024 + (r & 7) * 128 + (((c >> 3) ^ (r & 7)) * 16) + (c & 7) * 2; }
__host__ __device__ __forceinline__ void stage_rc8(int b, int& R, int& C) { const int sub = b / 1024, sb = b % 1024, rr = sb / 128, pos = (sb % 128) / 16; R = sub * 8 + rr; C = (pos ^ rr) * 8; }
__host__ __device__ __forceinline__ int perm32(int rho) { const int n = rho >> 4, i = rho & 15; return 8 * (i >> 2) + 4 * n + (i & 3); }

struct Unit { int pm, pn; };
struct Gemm { const bf16_t* A; const bf16_t* Bt; int M, N, K, lda, ldb, akoff; };

struct StaticOrder {
    int nM, nN, nwg, G, c;
    __host__ __device__ void init(int M, int N, int G_, int c_) { nM = M / BM; nN = N / BM; nwg = nM * nN; G = G_; c = c_; }
    __host__ __device__ bool next(int i, Unit& u) const {
        const long L = (long)i * G + c; if (L >= nwg) return false;
        int wgid = (int)L; { const int q = nwg / NXCD, r = nwg % NXCD, xcd = wgid % NXCD, off = wgid / NXCD; wgid = (xcd < r ? xcd * (q + 1) : r * (q + 1) + (xcd - r) * q) + off; }
        const int nig = WGM * nN, gid = wgid / nig, fm = gid * WGM, gsz = (nM - fm) < WGM ? (nM - fm) : WGM;
        u.pm = fm + ((wgid % nig) % gsz); u.pn = (wgid % nig) / gsz; return true;
    }
    __device__ __forceinline__ void a_ready(const Unit&) const {}
    __device__ __forceinline__ void done(const Unit&) const {}
};

__device__ __forceinline__ unsigned cvt_pk_bf16(float lo, float hi) { unsigned r; asm volatile("v_cvt_pk_bf16_f32 %0, %1, %2" : "=v"(r) : "v"(lo), "v"(hi)); return r; }

template <class Epi, class Sched, bool ALIGN_EPI = false, bool SP2 = false, bool LAYOUT8 = PG8_LAYOUT8, int ES = 2, bool I8 = false>
__device__ __forceinline__ void gemm_phase(PG8_LAS unsigned char* lds, const Gemm g, const Sched& S, const Epi& E, int wave_s) {
    const int tid = fresh_tid(wave_s);
    const int wid = __builtin_amdgcn_readfirstlane(tid >> 6), lane = tid & 63, wr = wid >> 2, wc = wid & 3, fr = lane & 15, fq = lane >> 4;
    constexpr bool FP8 = (ES == 1) && !I8; static_assert(ES == 2 || LAYOUT8, "1-byte operands use the line layout"); static_assert(!I8 || ES == 1, "int8 operands are 1 byte");
    const int K = g.K, nt = K / (ES == 1 ? 2 * BK : BK);
    unsigned voffA[2], voffB[2];
#pragma unroll
    for (int i = 0; i < 2; ++i) { int R, C; if (LAYOUT8) stage_rc8(tid * 16 + i * 8192, R, C); else stage_rc(tid * 16 + i * 8192, R, C); const int Rb = (Epi::BMAP == 2) ? (64 * (R >> 5) + 16 * ((R & 15) >> 2) + 4 * ((R >> 4) & 1) + (R & 3)) : (Epi::PERM ? ((R & ~31) + perm32(R & 31)) : R);
        voffA[i] = (unsigned)(R * g.lda * ES + C * 2); voffB[i] = (unsigned)(Rb * g.ldb * ES + C * 2); }
    const size_t kstep = (size_t)(BK * 2);
    const size_t hstepA = (size_t)HALF * g.lda * ES, hstepB = (size_t)((Epi::BMAP == 2) ? 8 : HALF) * g.ldb * ES;
    const size_t tstepA = 2 * hstepA, tstepB = (size_t)BM * g.ldb * ES;
    const size_t akb = (size_t)g.akoff * ES;
    const unsigned ldsw = (unsigned)wid * 1024u;
    const int aoffk[2] = {FP8 ? lds_byte8(wr * 64 + fr, 16 * fq) : LAYOUT8 ? lds_byte8(wr * 64 + fr, fq * 8) : lds_byte(wr * 64 + fr, fq * 8), FP8 ? lds_byte8(wr * 64 + fr, 16 * fq + 8) : LAYOUT8 ? lds_byte8(wr * 64 + fr, 32 + fq * 8) : lds_byte(wr * 64 + fr, fq * 8) + 1024};
    const int boffk[2] = {FP8 ? lds_byte8(wc * 32 + fr, 16 * fq) : LAYOUT8 ? lds_byte8(wc * 32 + fr, fq * 8) : lds_byte(wc * 32 + fr, fq * 8), FP8 ? lds_byte8(wc * 32 + fr, 16 * fq + 8) : LAYOUT8 ? lds_byte8(wc * 32 + fr, 32 + fq * 8) : lds_byte(wc * 32 + fr, fq * 8) + 1024};
#define PG8_SA(b, h) (((b) * 2 + (h)) * HTB)
#define PG8_SB(b, h) ((4 + (b) * 2 + (h)) * HTB)
#define PG8_STAGE(bufoff, gbase, voff) do { _Pragma("unroll") for (int _i = 0; _i < 2; ++_i) { asm volatile("" : "+v"((voff)[_i]));     \
        __builtin_amdgcn_global_load_lds((const unsigned*)((const char*)(gbase) + (voff)[_i]), (PG8_LAS unsigned*)(lds + (bufoff) + ldsw + _i * 8192), 16, 0, 0); } } while (0)
#define PG8_LD8(p0, p1) __builtin_shufflevector(*(const PG8_LAS v4i32*)(p0), *(const PG8_LAS v4i32*)(p1), 0, 1, 2, 3, 4, 5, 6, 7)
#define PG8_LDA(dst, b, h) do { if constexpr (FP8) { _Pragma("unroll") for (int m = 0; m < 4; ++m) dst##8[m] = PG8_LD8(lds + PG8_SA(b, h) + aoffk[0] + m * 2048, lds + PG8_SA(b, h) + aoffk[1] + m * 2048); } else { \
        _Pragma("unroll") for (int m = 0; m < 4; ++m) _Pragma("unroll") for (int k = 0; k < 2; ++k) dst[m][k] = *(const PG8_LAS bf16x8*)(lds + PG8_SA(b, h) + aoffk[k] + m * 2048); } } while (0)
#define PG8_LDB(dst, b, h) do { if constexpr (FP8) { _Pragma("unroll") for (int n = 0; n < 2; ++n) dst##8[n] = PG8_LD8(lds + PG8_SB(b, h) + boffk[0] + n * 2048, lds + PG8_SB(b, h) + boffk[1] + n * 2048); } else { \
        _Pragma("unroll") for (int n = 0; n < 2; ++n) _Pragma("unroll") for (int k = 0; k < 2; ++k) dst[n][k] = *(const PG8_LAS bf16x8*)(lds + PG8_SB(b, h) + boffk[k] + n * 2048); } } while (0)
#define PG8_MMA(ai, bj, At, Bt) do { __builtin_amdgcn_s_setprio(1); if constexpr (FP8) { _Pragma("unroll") for (int m = 0; m < 4; ++m) _Pragma("unroll") for (int n = 0; n < 2; ++n) \
        acc[ai][bj][m][n] = __builtin_amdgcn_mfma_scale_f32_16x16x128_f8f6f4(Bt##8[n], At##8[m], acc[ai][bj][m][n], 0, 0, 0, 0, 0, 0); } else { \
        _Pragma("unroll") for (int m = 0; m < 4; ++m) _Pragma("unroll") for (int n = 0; n < 2; ++n) _Pragma("unroll") for (int k = 0; k < 2; ++k) { \
        if constexpr (I8) acc[ai][bj][m][n] = __builtin_bit_cast(f32x4, __builtin_amdgcn_mfma_i32_16x16x64_i8(__builtin_bit_cast(v4i32, Bt[n][k]), __builtin_bit_cast(v4i32, At[m][k]), __builtin_bit_cast(v4i32, acc[ai][bj][m][n]), 0, 0, 0)); \
        else acc[ai][bj][m][n] = __builtin_amdgcn_mfma_f32_16x16x32_bf16(Bt[n][k], At[m][k], acc[ai][bj][m][n], 0, 0, 0); } } __builtin_amdgcn_s_setprio(0); } while (0)
#define PG8_WAIT_V(n) asm volatile("s_waitcnt vmcnt(" #n ")" ::: "memory")
#define PG8_WAIT_L(n) asm volatile("s_waitcnt lgkmcnt(" #n ")" ::: "memory")
#define PG8_BAR __builtin_amdgcn_s_barrier()
#define PG8_SCHED __builtin_amdgcn_sched_barrier(0)
    Unit cur, nxt; int ui = 0;
    if (!S.next(0, cur)) return;
    f32x4 acc[2][2][4][2];
#pragma unroll
    for (int a = 0; a < 2; ++a)
#pragma unroll
        for (int b = 0; b < 2; ++b)
#pragma unroll
            for (int m = 0; m < 4; ++m)
#pragma unroll
                for (int n = 0; n < 2; ++n) acc[a][b][m][n] = (f32x4){0.f, 0.f, 0.f, 0.f};
    bf16x8 At[4][2], B0[2][2], B1[2][2];
    v8i32 At8[4], B08[2], B18[2];
    const char* cA = (const char*)g.A + (size_t)cur.pm * tstepA + (size_t)cur.pn * akb; const char* cB = (const char*)g.Bt + (size_t)cur.pn * tstepB;
    S.a_ready(cur);
    if constexpr (SP2) {
        PG8_STAGE(PG8_SB(0, 0), cB, voffB); PG8_STAGE(PG8_SB(0, 1), cB + hstepB, voffB); PG8_STAGE(PG8_SA(0, 0), cA, voffA); PG8_STAGE(PG8_SA(0, 1), cA + hstepA, voffA);
        if (wr == 1) PG8_BAR;
        PG8_WAIT_V(2); PG8_BAR;
        PG8_STAGE(PG8_SB(1, 0), cB + kstep, voffB); PG8_STAGE(PG8_SA(1, 0), cA + kstep, voffA); PG8_STAGE(PG8_SB(1, 1), cB + hstepB + kstep, voffB);
        PG8_WAIT_V(6); PG8_BAR;
    } else {
        PG8_STAGE(PG8_SB(0, 0), cB, voffB); PG8_STAGE(PG8_SA(0, 0), cA, voffA); PG8_STAGE(PG8_SB(0, 1), cB + hstepB, voffB); PG8_STAGE(PG8_SA(0, 1), cA + hstepA, voffA);
        if (wr == 1) PG8_BAR;
        PG8_WAIT_V(4); PG8_BAR;
        PG8_STAGE(PG8_SB(1, 0), cB + kstep, voffB); PG8_STAGE(PG8_SA(1, 0), cA + kstep, voffA); PG8_STAGE(PG8_SB(1, 1), cB + hstepB + kstep, voffB);
        PG8_WAIT_V(6); PG8_BAR;
    }
    for (;;) {
        const bool has_next = S.next(ui + 1, nxt);
        const char* nA = has_next ? (const char*)g.A + (size_t)nxt.pm * tstepA + (size_t)nxt.pn * akb : cA; const char* nB = has_next ? (const char*)g.Bt + (size_t)nxt.pn * tstepB : cB;
        for (int t = 0; t < nt; t += 2) {
            const bool last = (t == nt - 2);
            const char* a1 = cA + (size_t)(t + 1) * kstep;
            const char* a2 = last ? nA : cA + (size_t)(t + 2) * kstep; const char* b2 = last ? nB : cB + (size_t)(t + 2) * kstep;
            const char* a3 = a2 + kstep; const char* b3 = b2 + kstep;
            if (last && has_next) S.a_ready(nxt);
            if constexpr (SP2) {
            PG8_LDB(B0, 0, 0); PG8_LDB(B1, 0, 1); PG8_SCHED; PG8_LDA(At, 0, 0); PG8_STAGE(PG8_SA(1, 1), a1 + hstepA, voffA);
            PG8_WAIT_V(8); PG8_WAIT_L(0); PG8_BAR; PG8_MMA(0, 0, At, B0); PG8_MMA(0, 1, At, B1); PG8_BAR; PG8_SCHED;
            PG8_LDA(At, 0, 1); PG8_STAGE(PG8_SB(0, 0), b2, voffB); PG8_STAGE(PG8_SB(0, 1), b2 + hstepB, voffB); PG8_STAGE(PG8_SA(0, 0), a2, voffA);
            PG8_WAIT_V(8); PG8_WAIT_L(0); PG8_BAR; PG8_MMA(1, 0, At, B0); PG8_MMA(1, 1, At, B1); PG8_BAR; PG8_SCHED;
            PG8_LDB(B0, 1, 0); PG8_LDB(B1, 1, 1); PG8_SCHED; PG8_LDA(At, 1, 0); PG8_STAGE(PG8_SA(0, 1), a2 + hstepA, voffA);
            PG8_WAIT_V(8); PG8_WAIT_L(0); PG8_BAR; PG8_MMA(0, 0, At, B0); PG8_MMA(0, 1, At, B1); PG8_BAR; PG8_SCHED;
            PG8_LDA(At, 1, 1); PG8_STAGE(PG8_SB(1, 0), b3, voffB); PG8_STAGE(PG8_SB(1, 1), b3 + hstepB, voffB); PG8_STAGE(PG8_SA(1, 0), a3, voffA);
            PG8_WAIT_V(8); PG8_WAIT_L(0); PG8_BAR; PG8_MMA(1, 0, At, B0); PG8_MMA(1, 1, At, B1); PG8_BAR; PG8_SCHED;
            } else {
            PG8_LDB(B0, 0, 0); PG8_SCHED; PG8_LDA(At, 0, 0); PG8_STAGE(PG8_SA(1, 1), a1 + hstepA, voffA);
            PG8_WAIT_L(8); PG8_BAR; PG8_WAIT_L(0); PG8_MMA(0, 0, At, B0); PG8_BAR; PG8_SCHED;
            PG8_LDB(B1, 0, 1); PG8_STAGE(PG8_SB(0, 0), b2, voffB);
            PG8_BAR; PG8_WAIT_L(0); PG8_MMA(0, 1, At, B1); PG8_BAR;
            PG8_LDA(At, 0, 1); PG8_STAGE(PG8_SA(0, 0), a2, voffA);
            PG8_BAR; PG8_WAIT_L(0); PG8_MMA(1, 0, At, B0); PG8_BAR; PG8_SCHED;
            PG8_STAGE(PG8_SB(0, 1), b2 + hstepB, voffB);
            PG8_WAIT_V(6); PG8_BAR; PG8_MMA(1, 1, At, B1); PG8_BAR;
            PG8_LDB(B0, 1, 0); PG8_SCHED; PG8_LDA(At, 1, 0); PG8_STAGE(PG8_SA(0, 1), a2 + hstepA, voffA);
            PG8_WAIT_L(8); PG8_BAR; PG8_WAIT_L(0); PG8_MMA(0, 0, At, B0); PG8_BAR; PG8_SCHED;
            PG8_LDB(B1, 1, 1); PG8_STAGE(PG8_SB(1, 0), b3, voffB);
            PG8_BAR; PG8_WAIT_L(0); PG8_MMA(0, 1, At, B1); PG8_BAR;
            PG8_LDA(At, 1, 1); PG8_STAGE(PG8_SA(1, 0), a3, voffA);
            PG8_BAR; PG8_WAIT_L(0); PG8_MMA(1, 0, At, B0); PG8_BAR; PG8_SCHED;
            PG8_STAGE(PG8_SB(1, 1), b3 + hstepB, voffB);
            PG8_WAIT_V(6); PG8_BAR; PG8_MMA(1, 1, At, B1); PG8_BAR;
            }
        }
        if constexpr (ALIGN_EPI) { if (wr == 0) PG8_BAR; }
        { const int l2 = fresh_tid(wave_s) & 63; E(acc, cur, wr, wc, l2 & 15, l2 >> 4); }
        S.done(cur);
        if (!has_next) break;
#pragma unroll
        for (int a = 0; a < 2; ++a)
#pragma unroll
            for (int b = 0; b < 2; ++b)
#pragma unroll
                for (int m = 0; m < 4; ++m)
#pragma unroll
                    for (int n = 0; n < 2; ++n) acc[a][b][m][n] = (f32x4){0.f, 0.f, 0.f, 0.f};
        cur = nxt; cA = nA; cB = nB; ++ui;
        if constexpr (ALIGN_EPI) { if (wr == 1) PG8_BAR; }
    }
    PG8_WAIT_V(0);
    if constexpr (!ALIGN_EPI) { if (wr == 0) PG8_BAR; }
    PG8_BAR;
#undef PG8_SA
#undef PG8_SB
#undef PG8_STAGE
#undef PG8_LDA
#undef PG8_LDB
#undef PG8_MMA
#undef PG8_LD8
#undef PG8_WAIT_V
#undef PG8_WAIT_L
#undef PG8_BAR
#undef PG8_SCHED
}
}

constexpr int NWAVES = 8, NTHR = NWAVES * 64;
constexpr int BATCH = 16, SEQ = 2048, DM = 2048, DEPTH = 4, FF = 8192;
constexpr int M = BATCH * SEQ;
constexpr int NHEAD = 16, QLORA = 512, KVL = 256, IDXD = 64, IDXH = 16, TOPK = 256, INC = 848, INCP = 1024;
constexpr int NQ = NHEAD * KVL + IDXH * IDXD;
constexpr float EPS = 1e-6f;
constexpr float QSCALE = 0.08838834764831845f * 1.4426950408889634f;

constexpr size_t MiB = 1u << 20;
constexpr size_t WS_CTL = 0, CTL_ZERO_BYTES = 4 * MiB;
constexpr size_t WS_RSS = 1 * MiB;
constexpr size_t WS_SBW = 3 * MiB + 768 * 1024;
constexpr size_t WS_WCA = 4 * MiB;
constexpr size_t WS_WCB = WS_WCA + 16 * MiB, WS_WCO = WS_WCA + 24 * MiB, CONV_W_STRIDE = 32 * MiB;
constexpr size_t WS_W1 = 68 * MiB, W1_STRIDE = 16 * MiB, WS_W2 = 132 * MiB, W2_STRIDE = 32 * MiB;
constexpr size_t WS_X8 = 260 * MiB;
constexpr size_t WS_WAI = 324 * MiB;
constexpr size_t WS_WQ = WS_WAI + 4 * MiB, WS_WUV = WS_WAI + 9 * MiB, WS_WAO = WS_WAI + 11 * MiB, ATT_W_STRIDE = 19 * MiB;
constexpr size_t WS_HB = 362 * MiB;
constexpr size_t WS_BIG = 490 * MiB;
constexpr size_t WS_A1 = WS_BIG;
constexpr size_t WS_Z = WS_BIG, WS_U = WS_BIG + 128 * MiB;
constexpr size_t WS_PROJ = WS_BIG;
constexpr size_t WS_O = WS_BIG + 384 * MiB;
static_assert(FP8_AO == 1, "the bf16 O buffer would not fit over q_idx");
constexpr size_t WS_QLAT = WS_BIG + 128 * MiB;
constexpr size_t WS_QIDX = WS_QLAT + 256 * MiB;
constexpr size_t WS_CQN = WS_QIDX + 64 * MiB;
constexpr size_t WS_CKV = WS_CQN + 32 * MiB;
constexpr size_t WS_KIDX = WS_CKV + 16 * MiB;
constexpr size_t WS_WIDX = WS_KIDX + 4 * MiB;
constexpr size_t WS_IDX = WS_WIDX + 2 * MiB;
constexpr size_t WS_END = 1024 * MiB;
static_assert(WS_IDX + 16 * MiB <= WS_END && WS_A1 + 512 * MiB <= WS_END && WS_WAI + 2 * ATT_W_STRIDE <= WS_HB && WS_W1 + 4 * W1_STRIDE <= WS_W2 && WS_W2 + 4 * W2_STRIDE <= WS_X8 && WS_X8 + 64 * MiB <= WS_WAI && WS_WCA + 2 * CONV_W_STRIDE <= WS_W1, "d_ws map");
constexpr int CW_TMO = 0, CW_CODE = 1, CW_BAR = 4096;

constexpr int LDS_PHASE_BYTES = 151552;
constexpr int LDSCTL_OFF = LDS_PHASE_BYTES, LDS_BYTES = LDSCTL_OFF + 512;

#define GAS __attribute__((address_space(1)))
#define LAS __attribute__((address_space(3)))
typedef unsigned short bf16;
typedef unsigned v4u __attribute__((ext_vector_type(4)));
typedef unsigned v2u __attribute__((ext_vector_type(2)));
typedef float f32x4 __attribute__((ext_vector_type(4)));
typedef GAS unsigned gu32;
#define RLX_AGENT __ATOMIC_RELAXED, __HIP_MEMORY_SCOPE_AGENT
#define LDS_WAIT() asm volatile("s_waitcnt lgkmcnt(0)" ::: "memory")
#define VM_WAIT() asm volatile("s_waitcnt vmcnt(0)" ::: "memory")
__device__ __forceinline__ unsigned f2bf(float f) { unsigned u = __builtin_bit_cast(unsigned, f); return (u + 0x7fffu + ((u >> 16) & 1u)) >> 16; }
__device__ __forceinline__ unsigned pk2(float lo, float hi) { return f2bf(lo) | (f2bf(hi) << 16); }
__device__ __forceinline__ float bflo(unsigned w) { return __builtin_bit_cast(float, w << 16); }
__device__ __forceinline__ float bfhi(unsigned w) { return __builtin_bit_cast(float, w & 0xffff0000u); }
__device__ __forceinline__ float bf2f(bf16 h) { return __builtin_bit_cast(float, (unsigned)h << 16); }

#define XB_TMO      128
#define XB_XCNT(j)  (256  + 64 * (j))
#define XB_XSUB(j)  (1280 + 64 * (j))
#define XB_XGEN(j)  (2304 + 64 * (j))
#define XB_TOP      3328
#define XB_TOPGEN   3392
#define XCD_BAR_WORDS 3456
#define XB_SPIN_CAP (1u << 18)
__device__ __forceinline__ unsigned xb_ld(unsigned* p)              { return __hip_atomic_load(p, __ATOMIC_RELAXED, __HIP_MEMORY_SCOPE_AGENT); }
__device__ __forceinline__ unsigned xb_add(unsigned* p, unsigned v) { return __hip_atomic_fetch_add(p, v, __ATOMIC_RELAXED, __HIP_MEMORY_SCOPE_AGENT); }
__device__ __forceinline__ unsigned xb_xcc_id() { return (unsigned)__builtin_amdgcn_s_getreg((3 << 11) | 20) & 0xFu; }
#define XB_SPIN(cond, bar) do { unsigned _sp = 0; while (cond) { __builtin_amdgcn_s_sleep(1); \
    if ((++_sp & 255u) == 0u) { if (xb_ld(&(bar)[XB_TMO])) break; if (_sp > XB_SPIN_CAP) { atomicAdd(&(bar)[XB_TMO], 1u); break; } } } } while (0)
struct XcdBarrier { unsigned* bar; unsigned x; volatile LAS unsigned* st; int wave_s; };
__device__ __forceinline__ XcdBarrier xcd_barrier_post(unsigned* bar, volatile LAS unsigned* st, int wave_s) {
    XcdBarrier b; b.bar = bar; b.x = xb_xcc_id(); b.st = st; b.wave_s = wave_s;
    if (fresh_tid(wave_s) == 0) (void)xb_add(&bar[XB_XCNT(b.x)], 1u);
    return b;
}
__device__ __forceinline__ void xcd_barrier_complete(unsigned* bar, unsigned x, unsigned& nloc, unsigned& nx) {
    const unsigned G = gridDim.x * gridDim.y * gridDim.z;
    unsigned sum, cnt, mine, sp = 0u;
    for (;;) {
        sum = 0u; cnt = 0u; mine = 0u;
#pragma unroll
        for (unsigned j = 0; j < 16; ++j) { const unsigned c = xb_ld(&bar[XB_XCNT(j)]); sum += c; cnt += (c > 0u) ? 1u : 0u; mine = (j == x) ? c : mine; }
        if (sum == G) break;
        __builtin_amdgcn_s_sleep(1);
        if ((++sp & 255u) == 0u) { if (xb_ld(&bar[XB_TMO])) break; if (sp > XB_SPIN_CAP) { atomicAdd(&bar[XB_TMO], 1u); break; } }
    }
    nloc = mine > 0u ? mine : 1u; nx = cnt > 0u ? cnt : 1u;
}
__device__ __forceinline__ void xcd_barrier(const XcdBarrier& b) {
    asm volatile("s_waitcnt vmcnt(0)" ::: "memory");
    __syncthreads();
    if (fresh_tid(b.wave_s) == 0) {
        unsigned* bar = b.bar;
        __builtin_amdgcn_s_waitcnt(0);
        unsigned nloc = b.st[0], nx = b.st[1];
        if (nloc == 0u) { xcd_barrier_complete(bar, b.x, nloc, nx); b.st[0] = nloc; b.st[1] = nx; }
        const unsigned old = xb_add(&bar[XB_XSUB(b.x)], 1u);
        const unsigned gen = old / nloc;
        if (old + 1u == (gen + 1u) * nloc) {
            __builtin_amdgcn_fence(__ATOMIC_RELEASE, "agent");
            asm volatile("s_waitcnt vmcnt(0)" ::: "memory");
            const unsigned og = xb_add(&bar[XB_TOP], 1u);
            const unsigned tg = og / nx;
            if (og + 1u == (tg + 1u) * nx) xb_add(&bar[XB_TOPGEN], 1u);
            else XB_SPIN(xb_ld(&bar[XB_TOPGEN]) == tg, bar);
            __builtin_amdgcn_fence(__ATOMIC_ACQUIRE, "agent");
            xb_add(&bar[XB_XGEN(b.x)], 1u);
            asm volatile("s_waitcnt vmcnt(0)" ::: "memory");
        } else {
            XB_SPIN(xb_ld(&bar[XB_XGEN(b.x)]) == gen, bar);
            __builtin_amdgcn_fence(__ATOMIC_ACQUIRE, "agent");
            asm volatile("s_waitcnt vmcnt(0)" ::: "memory");
        }
    }
    __syncthreads();
}

#define GB_WORD(g) (XCD_BAR_WORDS + 128 + 64 * (g))
__device__ __forceinline__ void grp_barrier(unsigned* bar, int grp, int wave_s) {
    asm volatile("s_waitcnt vmcnt(0)" ::: "memory");
    __syncthreads();
    if (fresh_tid(wave_s) == 0) {
        unsigned* cnt = bar + GB_WORD(grp);
        __builtin_amdgcn_fence(__ATOMIC_RELEASE, "agent");
        asm volatile("s_waitcnt vmcnt(0)" ::: "memory");
        const unsigned old = xb_add(cnt, 1u), target = (old / 32u + 1u) * 32u;
        XB_SPIN(xb_ld(cnt) < target, bar);
        __builtin_amdgcn_fence(__ATOMIC_ACQUIRE, "agent");
        asm volatile("s_waitcnt vmcnt(0)" ::: "memory");
    }
    __syncthreads();
}

#define XL_CNT(x) (XCD_BAR_WORDS + 1024 + 64 * (x))
#define XL_GEN(x) (XCD_BAR_WORDS + 2048 + 64 * (x))
#define XL_TAB    (XCD_BAR_WORDS + 3072)
__device__ __forceinline__ void grp_barrier_fast(unsigned* bar, unsigned x, int wave_s) {
    asm volatile("s_waitcnt vmcnt(0)" ::: "memory");
    __syncthreads();
    if (fresh_tid(wave_s) == 0) {
        const unsigned old = xb_add(&bar[XL_CNT(x)], 1u), gen = old / 32u;
        if (old + 1u == (gen + 1u) * 32u) {
            __builtin_amdgcn_fence(__ATOMIC_ACQUIRE, "agent");
            xb_add(&bar[XL_GEN(x)], 1u);
            asm volatile("s_waitcnt vmcnt(0)" ::: "memory");
        } else {
            XB_SPIN(xb_ld(&bar[XL_GEN(x)]) == gen, bar);
            __builtin_amdgcn_fence(__ATOMIC_ACQUIRE, "agent");
            asm volatile("s_waitcnt vmcnt(0)" ::: "memory");
        }
    }
    __syncthreads();
}

using pg8::Unit; using pg8::cvt_pk_bf16; using pg8::HALF;
typedef pg8::f32x4 accT[2][2][4][2];
typedef unsigned long long rss_t;
constexpr float RSS_SCALE = 16777216.0f;
__device__ __forceinline__ float rstd_raw(rss_t v) { return rsqrtf((float)v * (1.0f / (RSS_SCALE * DM)) + EPS); }
__device__ __forceinline__ float ms_raw(rss_t v) { return (float)v * (1.0f / (RSS_SCALE * DM)) + EPS; }
__device__ __forceinline__ float rstd_of(const rss_t* rss, int r) { return rsqrtf((float)rss[r] * (1.0f / (RSS_SCALE * DM)) + EPS); }

__device__ __forceinline__ unsigned pk4_fp8(float a, float b, float c, float d) { int w = 0; w = __builtin_amdgcn_cvt_pk_fp8_f32(a, b, w, false); w = __builtin_amdgcn_cvt_pk_fp8_f32(c, d, w, true); return (unsigned)w; }
constexpr float QC = 22.0f, WCLIP = 4.2f;
constexpr float QC0 = 30.0f;
__device__ __forceinline__ float ms_of(const rss_t* rss, int r) { return (float)rss[r] * (1.0f / (RSS_SCALE * DM)) + EPS; }
__device__ __forceinline__ unsigned pk4_i8(float a, float b, float c, float d) {
    unsigned w = 0;
    w = __builtin_amdgcn_cvt_pk_u8_f32(a + 128.0f, 0, w); w = __builtin_amdgcn_cvt_pk_u8_f32(b + 128.0f, 1, w);
    w = __builtin_amdgcn_cvt_pk_u8_f32(c + 128.0f, 2, w); w = __builtin_amdgcn_cvt_pk_u8_f32(d + 128.0f, 3, w);
    return w ^ 0x80808080u;
}
constexpr float HCLIP = 20.0f;
struct EpiRelu2H8 {
    static constexpr bool PERM = true; static constexpr int BMAP = 2;
    unsigned char* O; int ldc; const rss_t* rss; const rss_t* rss_q; const float* sbw; LAS unsigned char* cache;
    __device__ __forceinline__ void operator()(const accT& acc, const Unit& u, int wr, int wc, int fr, int fq) const {
        const int row0 = u.pm * 256 + wr * 64 + fr, col0 = u.pn * 256 + 64 * wc + 16 * fq; float kc = 3.570714214f / QC; asm volatile("" : "+s"(kc));
        const float sb = *sbw * kc;
        const int l64 = (fr + 16 * fq) & 63; LAS float* slot = (LAS float*)(cache + 32 * l64); LAS int* tagp = (LAS int*)(cache + 2048);
        float rs8[2][4];
        if (__builtin_amdgcn_readfirstlane(*tagp) != u.pm) {
            rss_t ra[2][4], rb[2][4];
#pragma unroll
            for (int ai = 0; ai < 2; ++ai)
#pragma unroll
                for (int m = 0; m < 4; ++m) { const int r = row0 + ai * HALF + m * 16; ra[ai][m] = rss[r]; rb[ai][m] = rss_q[r]; }
            __builtin_amdgcn_sched_barrier(0);
#pragma unroll
            for (int ai = 0; ai < 2; ++ai)
#pragma unroll
                for (int m = 0; m < 4; ++m) rs8[ai][m] = rstd_raw(ra[ai][m]) * sqrtf(ms_raw(rb[ai][m])) * sb;
            *(LAS f32x4*)slot = (f32x4){rs8[0][0], rs8[0][1], rs8[0][2], rs8[0][3]}; *(LAS f32x4*)(slot + 4) = (f32x4){rs8[1][0], rs8[1][1], rs8[1][2], rs8[1][3]};
            *tagp = u.pm;
        } else {
            const f32x4 c0 = *(const LAS f32x4*)slot, c1 = *(const LAS f32x4*)(slot + 4);
#pragma unroll
            for (int m = 0; m < 4; ++m) { rs8[0][m] = c0[m]; rs8[1][m] = c1[m]; }
        }
#pragma unroll
        for (int ai = 0; ai < 2; ++ai) {
            float rsv[4];
#pragma unroll
            for (int m = 0; m < 4; ++m) rsv[m] = rs8[ai][m];
#pragma unroll
            for (int m = 0; m < 4; ++m) { const int r = row0 + ai * HALF + m * 16; const float rs = rsv[m]; unsigned wd[4];
#pragma unroll
                for (int bj = 0; bj < 2; ++bj)
#pragma unroll
                    for (int n = 0; n < 2; ++n) { const pg8::f32x4 a4 = acc[ai][bj][m][n]; float q[4];
#pragma unroll
                        for (int e = 0; e < 4; ++e) { const float x = a4[e]; const float v = (float)__float_as_int(x) * rs; q[e] = v * fmaxf(v, 0.f); }
                        unsigned w = 0; w = __builtin_amdgcn_cvt_pk_u8_f32(q[0], 0, w); w = __builtin_amdgcn_cvt_pk_u8_f32(q[1], 1, w); w = __builtin_amdgcn_cvt_pk_u8_f32(q[2], 2, w); w = __builtin_amdgcn_cvt_pk_u8_f32(q[3], 3, w);
                        wd[2 * bj + n] = w ^ 0x80808080u; }
                *(pg8::u32x4*)(O + (size_t)r * ldc + col0) = (pg8::u32x4){wd[0], wd[1], wd[2], wd[3]}; }
            asm volatile("" ::: "memory");
        }
    }
};
struct EpiF8 {
    static constexpr bool PERM = true; static constexpr int BMAP = 2;
    unsigned char* O; int ldc; float sc;
    __device__ __forceinline__ void operator()(const accT& acc, const Unit& u, int wr, int wc, int fr, int fq) const {
        const int row0 = u.pm * 256 + wr * 64 + fr, col0 = u.pn * 256 + 64 * wc + 16 * fq;
#pragma unroll
        for (int ai = 0; ai < 2; ++ai)
#pragma unroll
            for (int m = 0; m < 4; ++m) { const int r = row0 + ai * HALF + m * 16; unsigned wd[4];
#pragma unroll
                for (int bj = 0; bj < 2; ++bj)
#pragma unroll
                    for (int n = 0; n < 2; ++n) { const pg8::f32x4 v = acc[ai][bj][m][n] * sc; wd[2 * bj + n] = pk4_fp8(v[0], v[1], v[2], v[3]); }
                *(pg8::u32x4*)(O + (size_t)r * ldc + col0) = (pg8::u32x4){wd[0], wd[1], wd[2], wd[3]}; }
    }
};
template <bool ACCI> __device__ __forceinline__ pg8::f32x4 acc_f(const pg8::f32x4 a) {
    if constexpr (ACCI) { const float x0 = a[0], x1 = a[1], x2 = a[2], x3 = a[3]; return (pg8::f32x4){(float)__float_as_int(x0), (float)__float_as_int(x1), (float)__float_as_int(x2), (float)__float_as_int(x3)}; }
    else return a;
}
constexpr float CQSC = 127.0f / 5.5f;
template <bool RS, bool ACCI = false> struct EpiBf16T {
    static constexpr bool PERM = true; static constexpr int BMAP = 1;
    bf16* O; int ldc; bf16* O2; int ldc2; int split; const rss_t* rsq = nullptr; const float* step1 = nullptr; const float* step2 = nullptr;
    __device__ __forceinline__ void operator()(const accT& acc, const Unit& u, int wr, int wc, int fr, int fq) const {
        if constexpr (ACCI) asm volatile("" ::: "memory");
        int colt = u.pn * 256; bf16* base = O; int ld = ldc; float cst = 1.0f; if constexpr (ACCI) cst = *step1 * (1.0f / CQSC);
        if (colt >= split) { colt -= split; base = O2; ld = ldc2; if constexpr (ACCI) cst = *step2 * (1.0f / CQSC); }
        const int row0 = u.pm * 256 + wr * 64 + fr, col0 = colt + wc * 32 + 8 * fq;
        float rsv[2][4]; rss_t rraw[2][4];
#pragma unroll
        for (int ai = 0; ai < 2; ++ai)
#pragma unroll
            for (int m = 0; m < 4; ++m) { rsv[ai][m] = cst; if constexpr (RS) rraw[ai][m] = rsq[row0 + ai * HALF + m * 16]; }
        if constexpr (RS) { __builtin_amdgcn_sched_barrier(0);
#pragma unroll
            for (int ai = 0; ai < 2; ++ai)
#pragma unroll
                for (int m = 0; m < 4; ++m) rsv[ai][m] *= rsqrtf((float)rraw[ai][m] * (1.0f / (RSS_SCALE * QLORA)) + EPS); }
#pragma unroll
        for (int ai = 0; ai < 2; ++ai)
#pragma unroll
            for (int m = 0; m < 4; ++m) { bf16* rowp = base + (size_t)(row0 + ai * HALF + m * 16) * ld + col0;
                const float rs = rsv[ai][m];
#pragma unroll
                for (int bj = 0; bj < 2; ++bj) { pg8::f32x4 v0 = acc_f<ACCI>(acc[ai][bj][m][0]), v1 = acc_f<ACCI>(acc[ai][bj][m][1]); if constexpr (RS || ACCI) { v0 = v0 * rs; v1 = v1 * rs; }
                    pg8::u32x4 w; w.x = cvt_pk_bf16(v0[0], v0[1]); w.y = cvt_pk_bf16(v0[2], v0[3]); w.z = cvt_pk_bf16(v1[0], v1[1]); w.w = cvt_pk_bf16(v1[2], v1[3]);
                    *(pg8::u32x4*)(rowp + bj * HALF) = w; } }
    }
};
typedef EpiBf16T<false> EpiBf16; typedef EpiBf16T<true> EpiBf16S; typedef EpiBf16T<true, true> EpiBf16SI;
template <bool ACCI> __device__ __forceinline__ float rowf(const rss_t* rss, const rss_t* rss_q, int r) {
    float f = rstd_of(rss, r); if constexpr (ACCI) f *= sqrtf(ms_of(rss_q, r)) * (1.0f / QC); return f;
}
template <bool ACCI> struct EpiRowScaleF32T {
    static constexpr bool PERM = false; static constexpr int BMAP = 0;
    float* C; int ldc; const rss_t* rss; const rss_t* rss_q = nullptr; const float* stepw = nullptr;
    __device__ __forceinline__ void operator()(const accT& acc, const Unit& u, int wr, int wc, int fr, int fq) const {
        const int row0 = u.pm * 256 + wr * 64 + fr, col0 = u.pn * 256 + wc * 32 + 4 * fq;
#pragma unroll
        for (int ai = 0; ai < 2; ++ai)
#pragma unroll
            for (int m = 0; m < 4; ++m) { const int r = row0 + ai * HALF + m * 16; const float rs = rowf<ACCI>(rss, rss_q, r) * (ACCI ? *stepw : 1.0f); float* rowp = C + (size_t)r * ldc + col0;
#pragma unroll
                for (int bj = 0; bj < 2; ++bj)
#pragma unroll
                    for (int n = 0; n < 2; ++n) *(pg8::f32x4*)(rowp + bj * HALF + n * 16) = acc_f<ACCI>(acc[ai][bj][m][n]) * rs; }
    }
};
typedef EpiRowScaleF32T<false> EpiRowScaleF32; typedef EpiRowScaleF32T<true> EpiRowScaleF32I;
struct EpiProjI {
    static constexpr bool PERM = false; static constexpr int BMAP = 0;
    float* C; int ldc; const rss_t* rss; const rss_t* rss_q; const float* stepw; unsigned char* CQN; rss_t* rsq_out;
    __device__ __forceinline__ void operator()(const accT& acc, const Unit& u, int wr, int wc, int fr, int fq) const {
        const int row0 = u.pm * 256 + wr * 64 + fr, col0 = u.pn * 256 + wc * 32 + 4 * fq; const float st = *stepw;
        if (u.pn < 2) {
#pragma unroll
            for (int ai = 0; ai < 2; ++ai) {
                float rsv[4]; rss_t ra[4], rb[4];
#pragma unroll
                for (int m = 0; m < 4; ++m) { const int r = row0 + ai * HALF + m * 16; ra[m] = rss[r]; rb[m] = rss_q[r]; }
                __builtin_amdgcn_sched_barrier(0);
#pragma unroll
                for (int m = 0; m < 4; ++m) rsv[m] = rstd_raw(ra[m]) * sqrtf(ms_raw(rb[m])) * (st * CQSC / QC);
#pragma unroll
                for (int m = 0; m < 4; ++m) { const int r = row0 + ai * HALF + m * 16; const float rs = rsv[m]; unsigned char* rowp = CQN + (size_t)r * QLORA + col0; float ss = 0.f;
#pragma unroll
                    for (int bj = 0; bj < 2; ++bj)
#pragma unroll
                        for (int n = 0; n < 2; ++n) { const pg8::f32x4 v = acc_f<true>(acc[ai][bj][m][n]) * rs; float t[4];
#pragma unroll
                            for (int e = 0; e < 4; ++e) { const float x = v[e]; t[e] = fminf(fmaxf(__builtin_rintf(x), -128.0f), 127.0f); ss += t[e] * t[e]; }
                            *(unsigned*)(rowp + bj * HALF + n * 16) = pk4_i8(t[0], t[1], t[2], t[3]); }
                    ss += __shfl_xor(ss, 16); ss += __shfl_xor(ss, 32);
                    if (fq == 0) atomicAdd(rsq_out + r, (rss_t)(ss * (RSS_SCALE / (CQSC * CQSC)))); }
                asm volatile("" ::: "memory"); }
        } else {
#pragma unroll
            for (int ai = 0; ai < 2; ++ai) {
                float rsv[4]; rss_t ra[4], rb[4];
#pragma unroll
                for (int m = 0; m < 4; ++m) { const int r = row0 + ai * HALF + m * 16; ra[m] = rss[r]; rb[m] = rss_q[r]; }
                __builtin_amdgcn_sched_barrier(0);
#pragma unroll
                for (int m = 0; m < 4; ++m) rsv[m] = rstd_raw(ra[m]) * sqrtf(ms_raw(rb[m])) * (st / QC);
#pragma unroll
                for (int m = 0; m < 4; ++m) { const int r = row0 + ai * HALF + m * 16; const float rs = rsv[m]; float* rowp = C + (size_t)r * ldc + col0;
#pragma unroll
                    for (int bj = 0; bj < 2; ++bj)
#pragma unroll
                        for (int n = 0; n < 2; ++n) *(pg8::f32x4*)(rowp + bj * HALF + n * 16) = acc_f<true>(acc[ai][bj][m][n]) * rs; }
                asm volatile("" ::: "memory"); }
        }
    }
};
template <bool ACCI> struct EpiZT {
    static constexpr bool PERM = true; static constexpr int BMAP = 1;
    bf16* Z;
    __device__ __forceinline__ void operator()(const accT& acc, const Unit& u, int wr, int wc, int fr, int fq) const {
        const int row0 = u.pm * 256 + wr * 64 + fr, col0 = u.pn * 128 + wc * 32 + 8 * fq;
#pragma unroll
        for (int ai = 0; ai < 2; ++ai)
#pragma unroll
            for (int m = 0; m < 4; ++m) { const int r = row0 + ai * HALF + m * 16;
                const pg8::f32x4 v0 = acc_f<ACCI>(acc[ai][0][m][0]) * acc_f<ACCI>(acc[ai][1][m][0]), v1 = acc_f<ACCI>(acc[ai][0][m][1]) * acc_f<ACCI>(acc[ai][1][m][1]);
                pg8::u32x4 w; w.x = cvt_pk_bf16(v0[0], v0[1]); w.y = cvt_pk_bf16(v0[2], v0[3]); w.z = cvt_pk_bf16(v1[0], v1[1]); w.w = cvt_pk_bf16(v1[2], v1[3]);
                *(pg8::u32x4*)(Z + (size_t)r * DM + col0) = w; }
    }
};
typedef EpiZT<false> EpiZ; typedef EpiZT<true> EpiZI;
template <bool ACCI, bool MIX = false, bool F8OUT = false> struct EpiUT {
    static constexpr bool PERM = true; static constexpr int BMAP = 1;
    bf16* U; const bf16* Z; const float* cw; const float* rfp; const float* step_a = nullptr; const float* step_b = nullptr;
    __device__ __forceinline__ void operator()(const accT& acc, const Unit& u, int wr, int wc, int fr, int fq) const {
        const int row0 = u.pm * 256 + wr * 64 + fr; const float sa = (ACCI && !MIX) ? *step_a : 1.0f; float sbb = ACCI ? *step_b : 1.0f; if constexpr (MIX) { float kq = 1.0f / QC0; asm volatile("" : "+s"(kq)); sbb *= kq; }
#pragma unroll
        for (int bj = 0; bj < 2; ++bj) { const int col0 = u.pn * 256 + bj * HALF + wc * 32 + 8 * fq;
            float w0[8], w1[8], w2[8];
#pragma unroll
            for (int e = 0; e < 8; ++e) { w0[e] = cw[col0 + e]; w1[e] = cw[DM + col0 + e]; w2[e] = cw[2 * DM + col0 + e]; }
#pragma unroll
            for (int ai = 0; ai < 2; ++ai)
#pragma unroll
                for (int m = 0; m < 4; ++m) { const int r = row0 + ai * HALF + m * 16, t = r & (SEQ - 1);
                    const int r1 = (t >= 1) ? r - 1 : r, r2 = (t >= 2) ? r - 2 : r;
                    const float f0 = rfp[r], f1 = rfp[r1], f2 = rfp[r2];
                    const v4u z2 = *(const v4u*)(Z + (size_t)r * DM + col0), z1 = *(const v4u*)(Z + (size_t)r1 * DM + col0), z0 = *(const v4u*)(Z + (size_t)r2 * DM + col0);
                    __builtin_amdgcn_sched_barrier(0);
                    const float rs = MIX ? sbb : f0 * sbb, ra = f0 * sa, qa = (t >= 1) ? f1 * sa : 0.f, qb = (t >= 2) ? f2 * sa : 0.f;
                    const float s2 = ra * ra, s1 = qa * qa, s0 = qb * qb;
                    float o[8];
#pragma unroll
                    for (int e2 = 0; e2 < 4; ++e2) {
                        const float c0 = w0[2 * e2] * s0 * bflo(z0[e2]) + w1[2 * e2] * s1 * bflo(z1[e2]) + w2[2 * e2] * s2 * bflo(z2[e2]);
                        const float c1 = w0[2 * e2 + 1] * s0 * bfhi(z0[e2]) + w1[2 * e2 + 1] * s1 * bfhi(z1[e2]) + w2[2 * e2 + 1] * s2 * bfhi(z2[e2]);
                        const pg8::f32x4 g0 = acc_f<ACCI>(acc[ai][bj][m][0]), g1 = acc_f<ACCI>(acc[ai][bj][m][1]);
                        const float b0 = (e2 < 2 ? g0[2 * e2] : g1[2 * e2 - 4]) * rs;
                        const float b1 = (e2 < 2 ? g0[2 * e2 + 1] : g1[2 * e2 - 3]) * rs;
                        o[2 * e2] = b0 * c0; o[2 * e2 + 1] = b1 * c1; }
                    if constexpr (F8OUT) {
#pragma unroll
                        for (int e = 0; e < 8; ++e) o[e] = __builtin_amdgcn_fmed3f(o[e] * 8.0f, -448.0f, 448.0f);
                        *(v2u*)((unsigned char*)U + (size_t)r * DM + col0) = (v2u){pk4_fp8(o[0], o[1], o[2], o[3]), pk4_fp8(o[4], o[5], o[6], o[7])}; }
                    else { pg8::u32x4 w; w.x = cvt_pk_bf16(o[0], o[1]); w.y = cvt_pk_bf16(o[2], o[3]); w.z = cvt_pk_bf16(o[4], o[5]); w.w = cvt_pk_bf16(o[6], o[7]);
                    *(pg8::u32x4*)(U + (size_t)r * DM + col0) = w; } } }
    }
};
typedef EpiUT<false> EpiU; typedef EpiUT<true> EpiUI; typedef EpiUT<true, true> EpiUM; typedef EpiUT<true, false, true> EpiUI8;
template <bool X8OUT, bool ACCI = false> struct EpiResT {
    static constexpr bool PERM = true; static constexpr int BMAP = 1;
    bf16* HB; rss_t* rss_out; const rss_t* rs2_in; float cscale; unsigned char* X8 = nullptr; const rss_t* rss_q = nullptr; const rss_t* rq_in = nullptr; const int* colsum = nullptr; const float* stepw = nullptr;
    __device__ __forceinline__ void operator()(const accT& acc, const Unit& u, int wr, int wc, int fr, int fq) const {
        const int row0 = u.pm * 256 + wr * 64 + fr, col0 = u.pn * 256 + wc * 32 + 8 * fq;
        float ssv[2][4];
        int zc[2][8]; float ics = 0.f;
        if constexpr (ACCI) { ics = *stepw * (HCLIP / 255.0f);
#pragma unroll
            for (int bj = 0; bj < 2; ++bj) { const pg8::u32x4 c0 = *(const pg8::u32x4*)(colsum + col0 + bj * HALF), c1 = *(const pg8::u32x4*)(colsum + col0 + bj * HALF + 4);
#pragma unroll
                for (int e = 0; e < 4; ++e) { zc[bj][e] = (int)c0[e] * 128; zc[bj][4 + e] = (int)c1[e] * 128; } } }

#pragma unroll
        for (int ai = 0; ai < 2; ++ai) {
            pg8::u32x4 hw[4][2]; float sc2[4], qs[4];
#pragma unroll
            for (int m = 0; m < 4; ++m)
#pragma unroll
                for (int bj = 0; bj < 2; ++bj) hw[m][bj] = *(const pg8::u32x4*)(HB + (size_t)(row0 + ai * HALF + m * 16) * DM + col0 + bj * HALF);
            rss_t qraw[4];
#pragma unroll
            for (int m = 0; m < 4; ++m) { sc2[m] = cscale; qs[m] = 0.f; if constexpr (X8OUT) qraw[m] = rss_q[row0 + ai * HALF + m * 16]; }
            if constexpr (X8OUT) { __builtin_amdgcn_sched_barrier(0);
#pragma unroll
                for (int m = 0; m < 4; ++m) qs[m] = QC * rstd_raw(qraw[m]); }
#pragma unroll
            for (int m = 0; m < 4; ++m) { const int r = row0 + ai * HALF + m * 16; const size_t off = (size_t)r * DM + col0; float ss = 0.f;
#pragma unroll
                for (int bj = 0; bj < 2; ++bj) { float hv[8]; const pg8::u32x4 w0 = hw[m][bj];
#pragma unroll
                    for (int e = 0; e < 4; ++e) { hv[2 * e] = bflo(w0[e]); hv[2 * e + 1] = bfhi(w0[e]); }
#pragma unroll
                    for (int e = 0; e < 4; ++e) {
                        if constexpr (ACCI) { const pg8::f32x4 a0 = acc[ai][bj][m][0], a1 = acc[ai][bj][m][1]; const float x0 = a0[e], x1 = a1[e];
                            hv[e] += (float)(__float_as_int(x0) + zc[bj][e]) * ics; hv[4 + e] += (float)(__float_as_int(x1) + zc[bj][4 + e]) * ics; }
                        else { hv[e] += acc[ai][bj][m][0][e] * sc2[m]; hv[4 + e] += acc[ai][bj][m][1][e] * sc2[m]; } }
                    pg8::u32x4 w; w.x = cvt_pk_bf16(hv[0], hv[1]); w.y = cvt_pk_bf16(hv[2], hv[3]); w.z = cvt_pk_bf16(hv[4], hv[5]); w.w = cvt_pk_bf16(hv[6], hv[7]);
                    *(pg8::u32x4*)(HB + off + bj * HALF) = w;
                    if constexpr (X8OUT) *(v2u*)(X8 + off + bj * HALF) = (v2u){pk4_i8(hv[0] * qs[m], hv[1] * qs[m], hv[2] * qs[m], hv[3] * qs[m]), pk4_i8(hv[4] * qs[m], hv[5] * qs[m], hv[6] * qs[m], hv[7] * qs[m])};
#pragma unroll
                    for (int e = 0; e < 4; ++e) { const float a = bflo(w[e]), b = bfhi(w[e]); ss += a * a + b * b; } }
                ssv[ai][m] = ss; }
            asm volatile("" ::: "memory");
        }
#pragma unroll
        for (int ai = 0; ai < 2; ++ai)
#pragma unroll
            for (int m = 0; m < 4; ++m) { float ss = ssv[ai][m]; ss += __shfl_xor(ss, 16); ss += __shfl_xor(ss, 32);
                if (fq == 0) atomicAdd(rss_out + row0 + ai * HALF + m * 16, (rss_t)(ss * RSS_SCALE)); }
    }
};

typedef EpiResT<false> EpiRes; typedef EpiResT<true> EpiResX8; typedef EpiResT<true, true> EpiResI; typedef EpiResT<false, true> EpiResIL;

__device__ __forceinline__ float wave_sum(float v) {
#pragma unroll
    for (int o = 1; o < 64; o <<= 1) v += __shfl_xor(v, o);
    return v;
}
__device__ __forceinline__ float wave_max(float v) {
#pragma unroll
    for (int o = 1; o < 64; o <<= 1) v = fmaxf(v, __shfl_xor(v, o));
    return v;
}
__device__ __forceinline__ void conv_item(const float* __restrict__ W, int ldw, int c0, int cvalid, const float* __restrict__ g, float gs, bf16* __restrict__ WT, int ldt, int drow0, int dcol0, int nblk, int item, int lane) {
    const int kb = item / nblk, nb = item % nblk, c = lane & 7, n4 = lane >> 3, k0 = 128 * kb + 8 * c, cs = c0 + 32 * nb + 4 * n4;
    f32x4 v[2][8];
#pragma unroll
    for (int hh = 0; hh < 2; ++hh)
#pragma unroll
        for (int i = 0; i < 8; ++i) { v[hh][i] = (f32x4){0.f, 0.f, 0.f, 0.f}; if (cs < cvalid) v[hh][i] = *(const f32x4*)(W + (size_t)(k0 + 64 * hh + i) * ldw + cs); }
#pragma unroll
    for (int hh = 0; hh < 2; ++hh) {
        if (g) {
            const f32x4 g0 = *(const f32x4*)(g + k0 + 64 * hh), g1 = *(const f32x4*)(g + k0 + 64 * hh + 4);
#pragma unroll
            for (int i = 0; i < 4; ++i) { v[hh][i] = v[hh][i] * (g0[i] * gs); v[hh][4 + i] = v[hh][4 + i] * (g1[i] * gs); }
        }
#pragma unroll
        for (int e = 0; e < 4; ++e) {
            v4u o; o.x = pk2(v[hh][0][e], v[hh][1][e]); o.y = pk2(v[hh][2][e], v[hh][3][e]); o.z = pk2(v[hh][4][e], v[hh][5][e]); o.w = pk2(v[hh][6][e], v[hh][7][e]);
            *(v4u*)(WT + (size_t)(drow0 + 32 * nb + 4 * n4 + e) * ldt + dcol0 + k0 + 64 * hh) = o; }
    }
}

__device__ __forceinline__ void conv_item_f8(const float* __restrict__ W, int ldw, const float* __restrict__ g, unsigned char* __restrict__ WT, int ldt, float scale, int nblk, int item, int lane) {
    const int kb = item / nblk, nb = item % nblk, c = lane & 7, n4 = lane >> 3, k0 = 128 * kb + 16 * c, cs = 32 * nb + 4 * n4;
    f32x4 v[16];
#pragma unroll
    for (int i = 0; i < 16; ++i) v[i] = *(const f32x4*)(W + (size_t)(k0 + i) * ldw + cs) * (g ? g[k0 + i] * scale : scale);
#pragma unroll
    for (int e = 0; e < 4; ++e) {
        v4u o; o.x = pk4_fp8(v[0][e], v[1][e], v[2][e], v[3][e]); o.y = pk4_fp8(v[4][e], v[5][e], v[6][e], v[7][e]); o.z = pk4_fp8(v[8][e], v[9][e], v[10][e], v[11][e]); o.w = pk4_fp8(v[12][e], v[13][e], v[14][e], v[15][e]);
        *(v4u*)(WT + (size_t)(32 * nb + 4 * n4 + e) * ldt + k0) = o; }
}

__device__ __forceinline__ float sample_step(const float* __restrict__ Ws, int ldw, const float* __restrict__ g, int lane) {
    const int c = lane & 7, n4 = lane >> 3; float ss = 0.f;
#pragma unroll
    for (int i = 0; i < 16; ++i) { const f32x4 t = *(const f32x4*)(Ws + (size_t)(16 * c + i) * ldw + 4 * n4) * (g ? g[16 * c + i] : 1.0f); ss += (t[0] * t[0] + t[1] * t[1]) + (t[2] * t[2] + t[3] * t[3]); }
    ss = wave_sum(ss);
    return WCLIP * sqrtf(ss * (1.0f / 4096.0f)) * (1.0f / 127.0f);
}
__device__ __forceinline__ void conv_item_i8(const float* __restrict__ W, int ldw, const float* __restrict__ g, unsigned char* __restrict__ WT, int ldt, float step, int nblk, int item, int lane, int* __restrict__ colsum = nullptr,
                                             int c0 = 0, int cvalid = 1 << 30, int drow0 = 0) {
    const int kb = item / nblk, nb = item % nblk, c = lane & 7, n4 = lane >> 3, k0 = 128 * kb + 16 * c, cs = c0 + 32 * nb + 4 * n4;
    f32x4 v[16];
#pragma unroll
    for (int i = 0; i < 16; ++i) { v[i] = (f32x4){0.f, 0.f, 0.f, 0.f}; if (cs < cvalid) v[i] = *(const f32x4*)(W + (size_t)(k0 + i) * ldw + cs) * (g ? g[k0 + i] : 1.0f); }
    const float inv = 1.0f / step;
#pragma unroll
    for (int e = 0; e < 4; ++e) {
        v4u o; o.x = pk4_i8(v[0][e] * inv, v[1][e] * inv, v[2][e] * inv, v[3][e] * inv); o.y = pk4_i8(v[4][e] * inv, v[5][e] * inv, v[6][e] * inv, v[7][e] * inv);
        o.z = pk4_i8(v[8][e] * inv, v[9][e] * inv, v[10][e] * inv, v[11][e] * inv); o.w = pk4_i8(v[12][e] * inv, v[13][e] * inv, v[14][e] * inv, v[15][e] * inv);
        *(v4u*)(WT + (size_t)(drow0 + 32 * nb + 4 * n4 + e) * ldt + k0) = o;
        if (colsum) {
            float cs4 = 0.f;
#pragma unroll
            for (int i = 0; i < 16; ++i) cs4 += fminf(fmaxf(__builtin_rintf(v[i][e] * inv), -128.0f), 127.0f);
            cs4 += __shfl_xor(cs4, 1); cs4 += __shfl_xor(cs4, 2); cs4 += __shfl_xor(cs4, 4);
            if (c == 0) atomicAdd(colsum + 32 * nb + 4 * n4 + e, (int)cs4); } }
}

__device__ __forceinline__ int wave_sum_i32(int v) {
    v += __builtin_amdgcn_update_dpp(0, v, 0xB1, 0xF, 0xF, false);
    v += __builtin_amdgcn_update_dpp(0, v, 0x4E, 0xF, 0xF, false);
    v += __builtin_amdgcn_update_dpp(0, v, 0x141, 0xF, 0xF, false);
    v += __builtin_amdgcn_update_dpp(0, v, 0x140, 0xF, 0xF, false);
    return __builtin_amdgcn_readlane(v, 0) + __builtin_amdgcn_readlane(v, 16) + __builtin_amdgcn_readlane(v, 32) + __builtin_amdgcn_readlane(v, 48);
}
template <int NCH> __device__ __forceinline__ void wave_topk256(const LAS float* sc, bf16* out, int lane) {
    constexpr int NK = 4 * NCH;
    unsigned key[NK];
#pragma unroll
    for (int r = 0; r < NCH; ++r) {
        f32x4 v = (f32x4){0.f, 0.f, 0.f, 0.f}; const bool have = true;
        v = *(const LAS f32x4*)(sc + 256 * r + 4 * lane);
#pragma unroll
        for (int e = 0; e < 4; ++e) { const float fe = v[e]; const unsigned uu = __float_as_uint(fe);
            const unsigned k = (uu & 0x80000000u) ? ~uu : (uu | 0x80000000u); key[4 * r + e] = have ? k : 0u; }
    }
    unsigned T = 0u; bool exact = false;
#pragma unroll 1
    for (int bit = 31; bit >= 0; --bit) {
        const unsigned cand = T | (1u << bit); int c = 0;
#pragma unroll
        for (int i = 0; i < NK; ++i) c += (key[i] >= cand) ? 1 : 0;
        const int cnt = wave_sum_i32(c);
        if (cnt >= TOPK) { T = cand; if (cnt == TOPK) { exact = true; break; } }
    }
    int need = 0;
    if (exact) T -= 1u;
    else { int c = 0;
#pragma unroll
        for (int i = 0; i < NK; ++i) c += (key[i] > T) ? 1 : 0;
        need = TOPK - wave_sum_i32(c); }
    int pos = 0;
    if (need == 0) {
#pragma unroll
        for (int i = 0; i < NK; ++i) {
            const bool sel = key[i] > T; const unsigned long long ms = __ballot(sel);
            const int p = pos + (int)__builtin_amdgcn_mbcnt_hi((unsigned)(ms >> 32), __builtin_amdgcn_mbcnt_lo((unsigned)ms, 0u));
            if (sel && p < TOPK) out[p] = (bf16)(256 * (i >> 2) + 4 * lane + (i & 3));
            pos += __popcll(ms);
        }
    } else {
        int tk = 0;
#pragma unroll
        for (int i = 0; i < NK; ++i) {
            const bool gt = key[i] > T, eq = key[i] == T;
            const unsigned long long meq = __ballot(eq);
            const int eqrank = tk + (int)__builtin_amdgcn_mbcnt_hi((unsigned)(meq >> 32), __builtin_amdgcn_mbcnt_lo((unsigned)meq, 0u));
            const bool sel = gt || (eq && eqrank < need);
            const unsigned long long ms = __ballot(sel);
            const int p = pos + (int)__builtin_amdgcn_mbcnt_hi((unsigned)(ms >> 32), __builtin_amdgcn_mbcnt_lo((unsigned)ms, 0u));
            if (sel && p < TOPK) out[p] = (bf16)(256 * (i >> 2) + 4 * lane + (i & 3));
            pos += __popcll(ms); tk += __popcll(meq);
        }
    }
}

typedef short bf16x8_t __attribute__((ext_vector_type(8)));
typedef short s16x4_t __attribute__((ext_vector_type(4)));
typedef float f4_t __attribute__((ext_vector_type(4)));
__device__ __forceinline__ s16x4_t lds_tr16(unsigned addr) {
    typedef short v4i16_t __attribute__((ext_vector_type(4)));
    return __builtin_bit_cast(s16x4_t, __builtin_amdgcn_ds_read_tr16_b64_v4i16((LAS v4i16_t*)(uintptr_t)addr));
}
constexpr int KST = 528;
constexpr int ATT_WAVE_LDS = 32 * KST + 512;

__device__ __forceinline__ void attn_query(const bf16* __restrict__ CKVb, const bf16* IDXrow, bf16* QO  , int nsel, LAS unsigned char* wl, int lane) {
    const int j = lane & 15, g = lane >> 4;
    LAS bf16* ids = (LAS bf16*)(wl + 32 * KST);
    *(LAS v2u*)(ids + 4 * lane) = *(const v2u*)(IDXrow + 4 * lane);
    bf16x8_t Bq[8];
#pragma unroll
    for (int s = 0; s < 8; ++s) Bq[s] = *(const bf16x8_t*)(QO + j * 256 + 32 * s + 8 * g);
    f4_t O[16];
#pragma unroll
    for (int d = 0; d < 16; ++d) O[d] = (f4_t){0.f, 0.f, 0.f, 0.f};
    float mrun = -__builtin_inff(), lsum = 0.f;
    const int nch = (nsel + 31) >> 5;
    asm volatile("s_waitcnt lgkmcnt(0)" ::: "memory");
    const unsigned wl_addr = (unsigned)(uintptr_t)wl;
    const unsigned a_rd = wl_addr + j * KST + 16 * g;
    const unsigned a_tr = wl_addr + (4 * g + (j >> 2)) * KST + 8 * (j & 3);
    v4u v[16];
#pragma unroll
    for (int p = 0; p < 16; ++p) { const int key = (int)ids[2 * p + (lane >> 5)];
        v[p] = *(const v4u*)(CKVb + (size_t)key * KVL + (lane & 31) * 8); }
    for (int c = 0; c < nch; ++c) {
#pragma unroll
        for (int p = 0; p < 16; ++p) *(LAS v4u*)(wl + (2 * p + (lane >> 5)) * KST + (lane & 31) * 16) = v[p];
        if (c + 1 < nch) {
#pragma unroll
            for (int p = 0; p < 16; ++p) { const int key = (int)ids[32 * (c + 1) + 2 * p + (lane >> 5)];
                v[p] = *(const v4u*)(CKVb + (size_t)key * KVL + (lane & 31) * 8); }
        }
        asm volatile("s_waitcnt lgkmcnt(0)" ::: "memory");
        f4_t S0 = (f4_t){0.f, 0.f, 0.f, 0.f}, S1 = (f4_t){0.f, 0.f, 0.f, 0.f};
#pragma unroll
        for (int s0 = 0; s0 < 8; s0 += ATT_RB) {
            bf16x8_t A0[ATT_RB], A1[ATT_RB];
#pragma unroll
            for (int q = 0; q < ATT_RB; ++q) { A0[q] = *(const LAS bf16x8_t*)(uintptr_t)(a_rd + 64 * (s0 + q)); A1[q] = *(const LAS bf16x8_t*)(uintptr_t)(a_rd + 16 * KST + 64 * (s0 + q)); }
            __builtin_amdgcn_sched_barrier(0);
#pragma unroll
            for (int q = 0; q < ATT_RB; ++q) { S0 = __builtin_amdgcn_mfma_f32_16x16x32_bf16(A0[q], Bq[s0 + q], S0, 0, 0, 0); S1 = __builtin_amdgcn_mfma_f32_16x16x32_bf16(A1[q], Bq[s0 + q], S1, 0, 0, 0); }
            __builtin_amdgcn_sched_barrier(0);
        }
        if (c == nch - 1) { const int kb = 32 * c + 4 * g;
#pragma unroll
            for (int i = 0; i < 4; ++i) { if (kb + i >= nsel) S0[i] = -__builtin_inff(); if (kb + 16 + i >= nsel) S1[i] = -__builtin_inff(); } }
        float mx = fmaxf(fmaxf(fmaxf(S0[0], S0[1]), fmaxf(S0[2], S0[3])), fmaxf(fmaxf(S1[0], S1[1]), fmaxf(S1[2], S1[3])));
        mx = fmaxf(mx, __shfl_xor(mx, 16)); mx = fmaxf(mx, __shfl_xor(mx, 32));
        const float mnew = fmaxf(mrun, mx), mrun0 = mrun;
        const float alpha = exp2f(mrun - mnew);
        float ps = 0.f; float p0[4], p1[4];
#pragma unroll
        for (int i = 0; i < 4; ++i) { p0[i] = exp2f(S0[i] - mnew); p1[i] = exp2f(S1[i] - mnew); ps += p0[i] + p1[i]; }
        lsum = lsum * alpha + ps; mrun = mnew;
        if (__any(mnew > mrun0)) {
#pragma unroll
            for (int d = 0; d < 16; ++d) O[d] = O[d] * alpha; }
        bf16x8_t Bp; { const unsigned w0 = pg8::cvt_pk_bf16(p0[0], p0[1]), w1 = pg8::cvt_pk_bf16(p0[2], p0[3]), w2 = pg8::cvt_pk_bf16(p1[0], p1[1]), w3 = pg8::cvt_pk_bf16(p1[2], p1[3]);
            Bp = __builtin_bit_cast(bf16x8_t, (v4u){w0, w1, w2, w3}); }
#pragma unroll
        for (int d0 = 0; d0 < 16; d0 += ATT_PB) {
            s16x4_t lo[ATT_PB], hi[ATT_PB];
#pragma unroll
            for (int q = 0; q < ATT_PB; ++q) { lo[q] = lds_tr16(a_tr + 32 * (d0 + q)); hi[q] = lds_tr16(a_tr + 16 * KST + 32 * (d0 + q)); }
            __builtin_amdgcn_sched_barrier(0);
#pragma unroll
            for (int q = 0; q < ATT_PB; ++q) { const bf16x8_t A = (bf16x8_t){lo[q][0], lo[q][1], lo[q][2], lo[q][3], hi[q][0], hi[q][1], hi[q][2], hi[q][3]};
                O[d0 + q] = __builtin_amdgcn_mfma_f32_16x16x32_bf16(A, Bp, O[d0 + q], 0, 0, 0); }
            __builtin_amdgcn_sched_barrier(0);
        }
        asm volatile("s_waitcnt lgkmcnt(0)" ::: "memory");
    }
    lsum += __shfl_xor(lsum, 16); lsum += __shfl_xor(lsum, 32);
    const float inv = 1.0f / lsum;
#pragma unroll
    for (int d = 0; d < 16; ++d) { const f4_t o = O[d] * inv; *(v2u*)(QO + j * 256 + 16 * d + 4 * g) = (v2u){pg8::cvt_pk_bf16(o[0], o[1]), pg8::cvt_pk_bf16(o[2], o[3])}; }
}

constexpr int SCST = 2192;
static_assert(2 * SCST * 4 >= ATT_WAVE_LDS && 16 * SCST * 4 + 1024 <= LDS_PHASE_BYTES, "indexer / attention LDS map");
__device__ __forceinline__ void index_unit(const bf16* __restrict__ QIDX, const bf16* __restrict__ KIDXb, const float* __restrict__ WIDX, bf16* IDX, const bf16* __restrict__ CKVb, bf16* QLAT, int b, int qt, LAS unsigned char* lds, int wave_s) {
    const int tid = fresh_tid(wave_s);
    const int lane = tid & 63, wave = __builtin_amdgcn_readfirstlane(tid >> 6);
    const int row0 = b * SEQ + 16 * qt;
    if (qt < 16) {
        const int e8 = tid * 8, k = e8 & 255;
        const unsigned k0 = (unsigned)k | ((unsigned)(k + 1) << 16), k1 = (unsigned)(k + 2) | ((unsigned)(k + 3) << 16), k2 = (unsigned)(k + 4) | ((unsigned)(k + 5) << 16), k3 = (unsigned)(k + 6) | ((unsigned)(k + 7) << 16);
        *(v4u*)(IDX + (size_t)row0 * TOPK + e8) = (v4u){k0, k1, k2, k3};
        __syncthreads();
#pragma unroll 1
        for (int qq = 0; qq < 2; ++qq) { const int row = row0 + 2 * wave + qq, t = row & (SEQ - 1);
            attn_query(CKVb, IDX + (size_t)row * TOPK, QLAT + (size_t)row * 4096, (t + 1 < TOPK) ? t + 1 : TOPK, lds + wave * (2 * SCST * 4), lane); }
        __syncthreads();
        return;
    }
    LAS float* sc = (LAS float*)lds;
    const int j = lane & 15, g = lane >> 4;
    constexpr int QST = 2048 + 16;
#pragma unroll
    for (int i = 0; i < 4; ++i) { const int pc = tid + NTHR * i, rw = pc >> 7, c16 = pc & 127;
        *(LAS v4u*)(lds + rw * QST + c16 * 16) = *(const v4u*)(QIDX + (size_t)(row0 + rw) * 1024 + c16 * 8); }
    LAS float* wl = (LAS float*)(lds + 16 * SCST * 4);
    if (tid < 256) wl[tid] = WIDX[(size_t)row0 * IDXH + tid];
    __syncthreads();
    bf16x8_t Bq[16][2];
#pragma unroll
    for (int h = 0; h < 16; ++h)
#pragma unroll
        for (int s2 = 0; s2 < 2; ++s2) Bq[h][s2] = *(const LAS bf16x8_t*)(lds + j * QST + h * 128 + s2 * 64 + g * 16);
    __syncthreads();
    const LAS float* wq = wl + j * IDXH;
    const int nT = qt + 1, nTpad = ((nT + 15) >> 4) << 4;
    const float ninf = -__builtin_inff();
    const bf16x8_t zf = (bf16x8_t){0, 0, 0, 0, 0, 0, 0, 0};
    bf16x8_t Pa0 = zf, Pa1 = zf, Pb0 = zf, Pb1 = zf, Pc0 = zf, Pc1 = zf;
    { const bf16* kp = KIDXb + (size_t)j * IDXD + 8 * g;
      if (wave < nT) { Pa0 = *(const bf16x8_t*)(kp + (size_t)(16 * wave) * IDXD); Pa1 = *(const bf16x8_t*)(kp + (size_t)(16 * wave) * IDXD + 32); }
      if (wave + NWAVES < nT) { Pb0 = *(const bf16x8_t*)(kp + (size_t)(16 * (wave + NWAVES)) * IDXD); Pb1 = *(const bf16x8_t*)(kp + (size_t)(16 * (wave + NWAVES)) * IDXD + 32); }
      if (wave + 2 * NWAVES < nT) { Pc0 = *(const bf16x8_t*)(kp + (size_t)(16 * (wave + 2 * NWAVES)) * IDXD); Pc1 = *(const bf16x8_t*)(kp + (size_t)(16 * (wave + 2 * NWAVES)) * IDXD + 32); } }
    for (int T = wave; T < nTpad; T += NWAVES) {
        f4_t score = (f4_t){ninf, ninf, ninf, ninf};
        const bf16x8_t A0 = Pa0, A1 = Pa1;
        Pa0 = Pb0; Pa1 = Pb1; Pb0 = Pc0; Pb1 = Pc1;
        if (T + 3 * NWAVES < nT) { const bf16* kp = KIDXb + (size_t)(16 * (T + 3 * NWAVES) + j) * IDXD + 8 * g; Pc0 = *(const bf16x8_t*)kp; Pc1 = *(const bf16x8_t*)(kp + 32); }
        if (T < nT) {
            score = (f4_t){0.f, 0.f, 0.f, 0.f};
#pragma unroll
            for (int h = 0; h < 16; ++h) {
                f4_t D = __builtin_amdgcn_mfma_f32_16x16x32_bf16(A0, Bq[h][0], (f4_t){0.f, 0.f, 0.f, 0.f}, 0, 0, 0);
                D = __builtin_amdgcn_mfma_f32_16x16x32_bf16(A1, Bq[h][1], D, 0, 0, 0);
                { const float wh = wq[h];
#pragma unroll
                for (int i = 0; i < 4; ++i) score[i] += wh * __builtin_amdgcn_fmed3f(D[i], 0.f, __builtin_inff()); }
                if ((h & 3) == 3) __builtin_amdgcn_sched_barrier(0);
            }
            if (T == qt) {
#pragma unroll
                for (int i = 0; i < 4; ++i) if (4 * g + i > j) score[i] = ninf;
            }
        }
        *(LAS f4_t*)(sc + j * SCST + 16 * T + 4 * g) = score;
    }
    __syncthreads();
#pragma unroll 1
    for (int qq = 0; qq < 2; ++qq) { const int q = 2 * wave + qq; const LAS float* sq = sc + q * SCST; bf16* oq = IDX + (size_t)(row0 + q) * TOPK;
        switch (qt >> 4) {
            case 1: wave_topk256<2>(sq, oq, lane); break; case 2: wave_topk256<3>(sq, oq, lane); break; case 3: wave_topk256<4>(sq, oq, lane); break;
            case 4: wave_topk256<5>(sq, oq, lane); break; case 5: wave_topk256<6>(sq, oq, lane); break; case 6: wave_topk256<7>(sq, oq, lane); break;
            default: wave_topk256<8>(sq, oq, lane); break; } }
    asm volatile("s_waitcnt vmcnt(0)" ::: "memory");
#pragma unroll 1
    for (int qq = 0; qq < 2; ++qq) { const int row = row0 + 2 * wave + qq;
        attn_query(CKVb, IDX + (size_t)row * TOPK, QLAT + (size_t)row * 4096, TOPK, lds + wave * (2 * SCST * 4), lane); }
    __syncthreads();
}

struct Args { const float* in[19]; float* out; unsigned char* ws; int ph_lo, ph_hi; };
constexpr int PH_PRO = 0, PH_PER_PAIR = 15, PH_FINAL = 1 + 2 * PH_PER_PAIR, N_PHASES = PH_FINAL + 1;

__global__ void __launch_bounds__(NTHR, 2) fwd(Args args) {
    extern __shared__ __attribute__((aligned(16))) unsigned char lds_raw[];
    LAS unsigned char* lds = (LAS unsigned char*)lds_raw;
    const int tid0 = threadIdx.x; const int wave_s = __builtin_amdgcn_readfirstlane(tid0 >> 6);
#define PHASE_IDS const int tid = fresh_tid(wave_s); const int lane = tid & 63, wave = wave_s; const int gw = blockIdx.x * NWAVES + wave, NGW = G * NWAVES; (void)lane; (void)gw; (void)NGW
    const int G = gridDim.x;
    unsigned char* ws = args.ws;
    gu32* ctl = (gu32*)(ws + WS_CTL);
    const int lo = args.ph_lo, hi = args.ph_hi;
    const float* x = args.in[0]; const float* norm_mix = args.in[1]; const float* norm_mlp = args.in[2]; const float* mlp_w1 = args.in[3]; const float* mlp_w2 = args.in[4];
    const float* conv_in = args.in[5]; const float* conv_w = args.in[6]; const float* conv_out = args.in[7]; const float* attn_in = args.in[8];
    const float* q_norm = args.in[9]; const float* kv_norm = args.in[10]; const float* w_uq = args.in[11]; const float* w_uk = args.in[12]; const float* w_uv = args.in[13];
    const float* w_qidx = args.in[14]; const float* ln_g = args.in[15]; const float* ln_b = args.in[16]; const float* attn_out = args.in[17]; const float* final_norm = args.in[18];
    bf16* HB = (bf16*)(ws + WS_HB);
    rss_t* RSS = (rss_t*)(ws + WS_RSS);
    float* SBW = (float*)(ws + WS_SBW);
    float* RFV = (float*)(ws + WS_SBW + 65536);
    int* COLSUM = (int*)(ws + WS_SBW + 4096);

    LAS unsigned* MISC = (LAS unsigned*)(lds + LDSCTL_OFF);
    for (int u = tid0; u < (LDS_BYTES - LDSCTL_OFF) / 4; u += NTHR) MISC[u] = 0u;
    __syncthreads();
    XcdBarrier bar; bar.bar = (unsigned*)(ctl + CW_BAR); bar.x = 0; bar.st = nullptr; bar.wave_s = wave_s;
    if (MK_ONE_LAUNCH) bar = xcd_barrier_post((unsigned*)(ctl + CW_BAR), (volatile LAS unsigned*)(MISC + 8), wave_s);
#define IN(k) (lo <= (k) && (k) < hi)
#define SEAM(k) do { if (IN(k) && IN((k) + 1)) xcd_barrier(bar); } while (0)
#define SEAM_G(k) do { if (IN(k) && IN((k) + 1)) { if (GROUP_SEAMS) { if (MISC[16]) grp_barrier_fast((unsigned*)(ctl + CW_BAR), bar.x, wave_s); else grp_barrier((unsigned*)(ctl + CW_BAR), (int)(blockIdx.x & 7), wave_s); } else xcd_barrier(bar); } } while (0)

    if (IN(PH_PRO)) {
        PHASE_IDS;
        {
        LAS float* stepL = (LAS float*)lds;
        for (int sl = wave; sl < 18; sl += NWAVES) {
            int lane_l = lane; asm volatile("" : "+v"(lane_l)); const int lane = lane_l;
            float st = 0.f; const int j = sl & 1;
            if (sl < 4) st = sample_step(mlp_w1 + (size_t)sl * DM * FF, FF, norm_mlp + (size_t)sl * DM, lane);
            else if (sl < 8) st = sample_step(mlp_w2 + (size_t)(sl - 4) * FF * DM, DM, nullptr, lane);
            else if (sl < 10) { if (j >= I8_CONV_FROM) st = sample_step(conv_in + (size_t)j * DM * 3 * DM + DM, 3 * DM, norm_mix + (size_t)(2 * j) * DM, lane); }
            else if (sl < 12) { if (j >= I8_CB_FROM) st = sample_step(conv_in + (size_t)j * DM * 3 * DM, 3 * DM, norm_mix + (size_t)(2 * j) * DM, lane); }
            else if (sl < 14) st = sample_step(attn_in + (size_t)j * DM * INC, INC, norm_mix + (size_t)(2 * j + 1) * DM, lane);
            else if (sl < 16) {
                const float* uq0 = w_uq + (size_t)j * QLORA * 2048; const float* uk0 = w_uk + (size_t)j * NHEAD * 128 * KVL + lane; const float* gq0 = q_norm + (size_t)j * QLORA;
                float a0[4] = {0.f, 0.f, 0.f, 0.f};
                for (int d = 0; d < 128; ++d) { const float bv = uk0[(size_t)d * KVL];
#pragma unroll
                    for (int i = 0; i < 4; ++i) a0[i] += uq0[(size_t)i * 2048 + d] * bv; }
                float ss = 0.f;
#pragma unroll
                for (int i = 0; i < 4; ++i) { const float t = a0[i] * gq0[i] * QSCALE; ss += t * t; }
                ss = wave_sum(ss); st = WCLIP * sqrtf(ss * (1.0f / 256.0f)) * (1.0f / 127.0f); }
            else st = sample_step(w_qidx + (size_t)j * QLORA * 1024, 1024, q_norm + (size_t)j * QLORA, lane);
            if (lane == 0) { stepL[sl] = st; if (blockIdx.x == 0) SBW[sl] = st; }
        }
        __syncthreads();
        constexpr int I_CA = (DM / 128) * (4096 / 32), I_CB = (DM / 128) * (DM / 32), I_CO = I_CB;
        constexpr int I_W1 = (DM / 128) * (FF / 32), I_W2 = (FF / 128) * (DM / 32);
        constexpr int I_AI = (DM / 128) * (INCP / 32), I_QI = (QLORA / 128) * (1024 / 32), I_UV = 16 * (KVL / 128) * (128 / 32), I_AO = I_CB;
        constexpr int PER_CONV = I_CA + I_CB + I_CO, PER_MLP = I_W1 + I_W2, PER_ATT = I_AI + I_QI + I_UV + I_AO;
        constexpr int NITEMS = 2 * PER_CONV + 4 * PER_MLP + 2 * PER_ATT;
#pragma unroll 1
        for (int pass = 0; pass < 2; ++pass) {
        const bool do_b = (((int)blockIdx.x & 1) != 0) == (pass == 0);
        if (!do_b) {
        for (int it = gw; it < NITEMS; it += NGW) {
            int lane_l = lane; asm volatile("" : "+v"(lane_l)); const int lane = lane_l;
            int r = it;
            if (r < 2 * PER_CONV) { const int j = r / PER_CONV; r -= j * PER_CONV;
                const float* Wi = conv_in + (size_t)j * DM * 3 * DM; const float* gn = norm_mix + (size_t)(2 * j) * DM;
                if (r < I_CA) {
                    const int nb = r % 128, kb = r / 128, pn = nb >> 3, which = (nb >> 2) & 1, i0 = (nb & 3) * 32;
                    if (j >= I8_CONV_FROM) conv_item_i8(Wi, 3 * DM, gn, (unsigned char*)(ws + WS_WCA + j * CONV_W_STRIDE), DM, stepL[8 + j], 1, kb, lane, nullptr, DM * (1 + which) + 128 * pn + i0, 3 * DM, 32 * nb);
                    else conv_item(Wi, 3 * DM, DM * (1 + which) + 128 * pn + i0, 3 * DM, gn, 1.f, (bf16*)(ws + WS_WCA + j * CONV_W_STRIDE), DM, 32 * nb, 0, 1, kb, lane);
                    continue; }
                r -= I_CA;
                if (r < I_CB) {
                    if (j >= I8_CB_FROM) conv_item_i8(Wi, 3 * DM, gn, (unsigned char*)(ws + WS_WCB + j * CONV_W_STRIDE), DM, stepL[10 + j], DM / 32, r, lane);
                    else conv_item(Wi, 3 * DM, 0, DM, gn, 1.f, (bf16*)(ws + WS_WCB + j * CONV_W_STRIDE), DM, 0, 0, DM / 32, r, lane);
                    continue; }
                r -= I_CB;
                if (j >= F8_CO_FROM) conv_item_f8(conv_out + (size_t)j * DM * DM, DM, nullptr, (unsigned char*)(ws + WS_WCO + j * CONV_W_STRIDE), DM, 64.0f, DM / 32, r, lane);
                else conv_item(conv_out + (size_t)j * DM * DM, DM, 0, DM, nullptr, 1.f, (bf16*)(ws + WS_WCO + j * CONV_W_STRIDE), DM, 0, 0, DM / 32, r, lane);
                continue; }
            r -= 2 * PER_CONV;
            if (r < 4 * PER_MLP) { const int i = r / PER_MLP; r -= i * PER_MLP;
                if (r < I_W1) {
                    conv_item_i8(mlp_w1 + (size_t)i * DM * FF, FF, norm_mlp + (size_t)i * DM, (unsigned char*)(ws + WS_W1 + i * W1_STRIDE), DM, stepL[i], FF / 32, r, lane);
                    continue; }
                r -= I_W1;
                conv_item_i8(mlp_w2 + (size_t)i * FF * DM, DM, nullptr, (unsigned char*)(ws + WS_W2 + i * W2_STRIDE), FF, stepL[4 + i], DM / 32, r, lane, COLSUM + i * DM);
                continue; }
            r -= 4 * PER_MLP;
            { const int j = r / PER_ATT; r -= j * PER_ATT;
                if (r < I_AI) { conv_item_i8(attn_in + (size_t)j * DM * INC, INC, norm_mix + (size_t)(2 * j + 1) * DM, (unsigned char*)(ws + WS_WAI + j * ATT_W_STRIDE), DM, stepL[12 + j], INCP / 32, r, lane, nullptr, 0, INC); continue; }
                r -= I_AI;
                if (r < I_QI) { conv_item_i8(w_qidx + (size_t)j * QLORA * 1024, 1024, q_norm + (size_t)j * QLORA, (unsigned char*)(ws + WS_WQ + j * ATT_W_STRIDE), QLORA, stepL[16 + j], 1024 / 32, r, lane, nullptr, 0, 1 << 30, 4096); continue; }
                r -= I_QI;
                if (r < I_UV) {
                    const int h = r / 8, rr = r % 8;
                    conv_item(w_uv + (size_t)j * NHEAD * KVL * 128 + (size_t)h * KVL * 128, 128, 0, 128, nullptr, 1.f, (bf16*)(ws + WS_WUV + j * ATT_W_STRIDE), 512, h * 128, (h & 1) * 256, 4, rr, lane); continue; }
                r -= I_UV;
                if (FP8_AO) conv_item_f8(attn_out + (size_t)j * DM * DM, DM, nullptr, (unsigned char*)(ws + WS_WAO + j * ATT_W_STRIDE), DM, 64.0f, DM / 32, r, lane);
                else conv_item(attn_out + (size_t)j * DM * DM, DM, 0, DM, nullptr, 1.f, (bf16*)(ws + WS_WAO + j * ATT_W_STRIDE), DM, 0, 0, DM / 32, r, lane); }
        }
        for (int it = gw; it < 2 * 2048; it += NGW) { const int j = it >> 11, n = it & 2047, h = n >> 7;
            bf16* p = (bf16*)(ws + WS_WUV + j * ATT_W_STRIDE) + (size_t)n * 512 + (1 - (h & 1)) * 256;
            *(v2u*)(p + 4 * lane) = (v2u){0u, 0u}; }
        } else {
        for (int it = gw; it < 2 * 16 * 32 * 4; it += NGW) {
            const int cb = it & 3, rb = (it >> 2) & 31, h = (it >> 7) & 15, j = it >> 11;
            const float* uq = w_uq + (size_t)j * QLORA * 2048 + (size_t)(rb * 16) * 2048 + h * 128;
            const float* uk = w_uk + (size_t)j * NHEAD * 128 * KVL + (size_t)h * 128 * KVL + cb * 64 + lane;
            float a[16];
#pragma unroll
            for (int i = 0; i < 16; ++i) a[i] = 0.f;
            LAS float* aL = (LAS float*)(lds + 1024 + wave * 8192);
#pragma unroll
            for (int q = 0; q < 8; ++q) { const int f = 4 * (lane + 64 * q); *(LAS f32x4*)(aL + f) = *(const f32x4*)(uq + (size_t)(f >> 7) * 2048 + (f & 127)); }
#pragma unroll 2
            for (int d = 0; d < 128; d += 8) { float bv[8];
#pragma unroll
                for (int t = 0; t < 8; ++t) bv[t] = uk[(size_t)(d + t) * KVL];
#pragma unroll
                for (int i = 0; i < 16; ++i) { const f32x4 a0 = *(const LAS f32x4*)(aL + i * 128 + d), a1 = *(const LAS f32x4*)(aL + i * 128 + d + 4);
                    a[i] += (a0[0] * bv[0] + a0[1] * bv[1]) + (a0[2] * bv[2] + a0[3] * bv[3]) + (a1[0] * bv[4] + a1[1] * bv[5]) + (a1[2] * bv[6] + a1[3] * bv[7]); } }
            const float* gq = q_norm + (size_t)j * QLORA + rb * 16;
            const float inv = 1.0f / stepL[14 + j];
            float q[16];
#pragma unroll
            for (int i = 0; i < 16; ++i) q[i] = a[i] * gq[i] * QSCALE * inv;
            unsigned char* dst = (unsigned char*)(ws + WS_WQ + j * ATT_W_STRIDE) + (size_t)(h * 256 + cb * 64 + lane) * QLORA + rb * 16;
            *(v4u*)dst = (v4u){pk4_i8(q[0], q[1], q[2], q[3]), pk4_i8(q[4], q[5], q[6], q[7]), pk4_i8(q[8], q[9], q[10], q[11]), pk4_i8(q[12], q[13], q[14], q[15])};
        }
        } }
        for (int m = gw; m < M; m += NGW) {
            const f32x4* xr = (const f32x4*)(x + (size_t)m * DM) + lane; float s = 0.f; f32x4 v[8];
#pragma unroll
            for (int j = 0; j < 8; ++j) { v[j] = xr[64 * j]; s += (v[j][0] * v[j][0] + v[j][1] * v[j][1]) + (v[j][2] * v[j][2] + v[j][3] * v[j][3]); }
            s = wave_sum(s);
            v2u* o8 = (v2u*)(HB + (size_t)m * DM) + lane;
#pragma unroll
            for (int j = 0; j < 8; ++j) o8[64 * j] = (v2u){pk2(v[j][0], v[j][1]), pk2(v[j][2], v[j][3])};
            if (lane == 0) RSS[m] = (rss_t)(s * RSS_SCALE);
            if (I8_CB_FROM == 0) {
                const float rq = QC0 * rstd_raw((rss_t)(s * RSS_SCALE)); unsigned* q8 = (unsigned*)(ws + WS_X8 + (size_t)m * DM) + lane;
#pragma unroll
                for (int j = 0; j < 8; ++j) q8[64 * j] = pk4_i8(v[j][0] * rq, v[j][1] * rq, v[j][2] * rq, v[j][3] * rq); }
        }
        }
    }
    if (GROUP_SEAMS && MK_ONE_LAUNCH && IN(PH_PRO) && tid0 == 0) ((unsigned*)(ctl + CW_BAR))[XL_TAB + blockIdx.x] = bar.x + 1u;
    SEAM(PH_PRO);
    if (GROUP_SEAMS && MK_ONE_LAUNCH && IN(PH_PRO) && IN(PH_PRO + 1)) {
        if (wave_s == 0) { const int ln = fresh_tid(0); const unsigned mine = bar.x + 1u;
            const unsigned v = (ln < 32) ? xb_ld(&((unsigned*)(ctl + CW_BAR))[XL_TAB + 8 * ln + (blockIdx.x & 7)]) : mine;
            const bool ok = __all(v == mine) && (MISC[8] == 32u);
            if (ln == 0) MISC[16] = ok ? 1u : 0u; }
        __syncthreads();
    }

    for (int i = 0; i < DEPTH; ++i) {
        const int j = i >> 1;
        const int pb = 1 + j * PH_PER_PAIR + ((i & 1) ? 5 : 0);
        rss_t* rss_mix = RSS + (size_t)(2 * i) * M; rss_t* rss_mlp = RSS + (size_t)(2 * i + 1) * M; rss_t* rss_next = RSS + (size_t)(2 * i + 2) * M;
        int pm;
        if ((i & 1) == 0) {
            bf16* Z = (bf16*)(ws + WS_Z); bf16* U = (bf16*)(ws + WS_U);
            const rss_t* rss_pq = rss_mix - M;
            if (IN(pb + 0)) {
                pg8::StaticOrder S; S.init(M, 4096, G, (int)blockIdx.x);
                if (j >= I8_CONV_FROM) { pg8::Gemm g{(const bf16*)(ws + WS_X8), (const bf16*)(ws + WS_WCA + j * CONV_W_STRIDE), M, 4096, DM, DM, DM, 0}; EpiZI E{Z}; pg8::gemm_phase<EpiZI, pg8::StaticOrder, true, true, PG8_LAYOUT8, 1, true>(lds, g, S, E, wave_s); }
                else { pg8::Gemm g{HB, (const bf16*)(ws + WS_WCA + j * CONV_W_STRIDE), M, 4096, DM, DM, DM, 0}; EpiZ E{Z}; pg8::gemm_phase<EpiZ, pg8::StaticOrder, true, true>(lds, g, S, E, wave_s); }
                { const int tid = fresh_tid(wave_s);
                  if (tid < M / 256) { const int row = 4096 * (int)(blockIdx.x & 7) + (int)(blockIdx.x >> 3) * (M / 256) + tid;   RFV[row] = (j >= I8_CONV_FROM) ? rowf<true>(rss_mix, rss_pq, row) : rowf<false>(rss_mix, nullptr, row); } }
            }
            SEAM_G(pb + 0);
            if (IN(pb + 1)) {
                pg8::StaticOrder S; S.init(M, DM, G, (int)blockIdx.x);
                if (j >= I8_CONV_FROM) { pg8::Gemm g{(const bf16*)(ws + WS_X8), (const bf16*)(ws + WS_WCB + j * CONV_W_STRIDE), M, DM, DM, DM, DM, 0}; static_assert(F8_CO_FROM == I8_CONV_FROM, "the int8 input projections' layers store u as e4m3"); EpiUI8 E{U, Z, conv_w + (size_t)j * 3 * DM, RFV, SBW + 8 + j, SBW + 10 + j};
                    pg8::gemm_phase<EpiUI8, pg8::StaticOrder, true, true, PG8_LAYOUT8, 1, true>(lds, g, S, E, wave_s); }
                else if (j >= I8_CB_FROM) { pg8::Gemm g{(const bf16*)(ws + WS_X8), (const bf16*)(ws + WS_WCB + j * CONV_W_STRIDE), M, DM, DM, DM, DM, 0}; EpiUM E{U, Z, conv_w + (size_t)j * 3 * DM, RFV, nullptr, SBW + 10 + j};
                    pg8::gemm_phase<EpiUM, pg8::StaticOrder, true, true, PG8_LAYOUT8, 1, true>(lds, g, S, E, wave_s); }
                else { pg8::Gemm g{HB, (const bf16*)(ws + WS_WCB + j * CONV_W_STRIDE), M, DM, DM, DM, DM, 0}; EpiU E{U, Z, conv_w + (size_t)j * 3 * DM, RFV};
                    pg8::gemm_phase<EpiU, pg8::StaticOrder, true, true>(lds, g, S, E, wave_s); }
            }
            SEAM_G(pb + 1);
            if (IN(pb + 2)) {
                pg8::Gemm g{U, (const bf16*)(ws + WS_WCO + j * CONV_W_STRIDE), M, DM, DM, DM, DM, 0}; pg8::StaticOrder S; S.init(M, DM, G, (int)blockIdx.x);
                if (j >= F8_CO_FROM) { EpiResX8 E{HB, rss_mlp, nullptr, 1.0f / 512.0f, ws + WS_X8, rss_mix}; pg8::gemm_phase<EpiResX8, pg8::StaticOrder, true, true, PG8_LAYOUT8, 1>(lds, g, S, E, wave_s); }
                else { EpiResX8 E{HB, rss_mlp, nullptr, 1.0f, ws + WS_X8, rss_mix}; pg8::gemm_phase<EpiResX8, pg8::StaticOrder, true, true>(lds, g, S, E, wave_s); }
            }
            SEAM_G(pb + 2);
            pm = pb + 3;
        } else {
            float* PROJ = (float*)(ws + WS_PROJ); bf16* CQN = (bf16*)(ws + WS_CQN); bf16* CKV = (bf16*)(ws + WS_CKV); bf16* KIDX = (bf16*)(ws + WS_KIDX); float* WIDX = (float*)(ws + WS_WIDX);
            bf16* QLAT = (bf16*)(ws + WS_QLAT); bf16* QIDX = (bf16*)(ws + WS_QIDX); bf16* IDX = (bf16*)(ws + WS_IDX); bf16* O = (bf16*)(ws + WS_O);
            if (IN(pb + 0)) {
                pg8::Gemm g{(const bf16*)(ws + WS_X8), (const bf16*)(ws + WS_WAI + j * ATT_W_STRIDE), M, INCP, DM, DM, DM, 0}; pg8::StaticOrder S; S.init(M, INCP, G, (int)blockIdx.x);
                EpiProjI E{PROJ, INCP, rss_mix, rss_mix - M, SBW + 12 + j, (unsigned char*)CQN, RSS + (size_t)(9 + j) * M};
                pg8::gemm_phase<EpiProjI, pg8::StaticOrder, true, true, PG8_LAYOUT8, 1, true>(lds, g, S, E, wave_s);
            }
            SEAM_G(pb + 0);
            if (IN(pb + 2)) {
                {
                    PHASE_IDS;
                    const float* kvg = kv_norm + (size_t)j * KVL; const float* lg = ln_g + (size_t)j * IDXD; const float* lb = ln_b + (size_t)j * IDXD;
                    const f32x4 gk = *(const f32x4*)(kvg + 4 * lane); const float lgl = lg[lane], lbl = lb[lane];
                    const int gwl = (int)(blockIdx.x >> 3) * NWAVES + wave, rbase = 4096 * (int)(blockIdx.x & 7);
                    for (int m0 = rbase + gwl; m0 < rbase + 4096; m0 += 2 * 256) {
                        f32x4 kv[2]; float ki[2], wi[2];
#pragma unroll
                        for (int rr = 0; rr < 2; ++rr) { const float* pr = PROJ + (size_t)(m0 + rr * 256) * INCP;
                            kv[rr] = *(const f32x4*)(pr + 512 + 4 * lane); ki[rr] = pr[768 + lane]; wi[rr] = (lane < 16) ? pr[832 + lane] : 0.f; }
#pragma unroll
                        for (int rr = 0; rr < 2; ++rr) { const int m = m0 + rr * 256;
                            float sk = (kv[rr][0] * kv[rr][0] + kv[rr][1] * kv[rr][1]) + (kv[rr][2] * kv[rr][2] + kv[rr][3] * kv[rr][3]);
                            sk = wave_sum(sk);
                            const float rk = rsqrtf(sk * (1.0f / KVL) + EPS);
                            const float mu = wave_sum(ki[rr]) * (1.0f / IDXD); const float dk = ki[rr] - mu; const float var = wave_sum(dk * dk) * (1.0f / IDXD);
                            const float kn = dk * rsqrtf(var + EPS) * lgl + lbl;
                            *(v2u*)(CKV + (size_t)m * KVL + 4 * lane) = (v2u){pk2(kv[rr][0] * rk * gk[0], kv[rr][1] * rk * gk[1]), pk2(kv[rr][2] * rk * gk[2], kv[rr][3] * rk * gk[3])};
                            KIDX[(size_t)m * IDXD + lane] = (bf16)f2bf(kn);
                            if (lane < 16) WIDX[(size_t)m * IDXH + lane] = wi[rr] * 0.03125f; }
                    }
                }
                pg8::Gemm g{CQN, (const bf16*)(ws + WS_WQ + j * ATT_W_STRIDE), M, NQ, QLORA, QLORA, QLORA, 0}; pg8::StaticOrder S; S.init(M, NQ, G, (int)blockIdx.x);
                EpiBf16SI E{QLAT, 4096, QIDX, 1024, 4096, RSS + (size_t)(9 + j) * M, SBW + 14 + j, SBW + 16 + j};
                pg8::gemm_phase<EpiBf16SI, pg8::StaticOrder, true, true, PG8_LAYOUT8, 1, true>(lds, g, S, E, wave_s);
            }
            SEAM_G(pb + 2);
            if (IN(pb + 3)) {
                PHASE_IDS;
                const int grp = blockIdx.x & 7, r = blockIdx.x >> 3;
                for (int u = 0; u < 8; ++u) {
                    const int b = 2 * grp + ((u & 7) >> 2), v = u & 3, qt = (v == 0) ? r : (v == 1) ? 63 - r : (v == 2) ? 64 + r : 127 - r;
                    index_unit(QIDX, KIDX + (size_t)b * SEQ * IDXD, WIDX, IDX, CKV + (size_t)b * SEQ * KVL, QLAT, b, qt, lds, wave_s);
                }
            }
            SEAM_G(pb + 3);
#if 0
            if (IN(pb + 4)) {
                PHASE_IDS;
                const int grp = blockIdx.x & 7, rk = (blockIdx.x >> 3) * NWAVES + wave, nrk = (G >> 3) * NWAVES;
                LAS unsigned char* wl = lds + wave * ATT_WAVE_LDS;
                for (int q = rk; q < 2 * SEQ; q += nrk) {
                    const int row = (2 * grp) * SEQ + q, t = row & (SEQ - 1), b = row >> 11, nsel = (t + 1 < TOPK) ? t + 1 : TOPK;
                    attn_query(CKV + (size_t)b * SEQ * KVL, IDX + (size_t)row * TOPK, QLAT + (size_t)row * 4096, nsel, wl, lane);
                }
                __syncthreads();
            }
            SEAM(pb + 4);
#endif
            if (IN(pb + 5)) {
                pg8::Gemm g{QLAT, (const bf16*)(ws + WS_WUV + j * ATT_W_STRIDE), M, DM, 512, 4096, 512, 512}; pg8::StaticOrder S; S.init(M, DM, G, (int)blockIdx.x);
                if (FP8_AO) { EpiF8 E{(unsigned char*)O, DM, 8.0f}; pg8::gemm_phase<EpiF8, pg8::StaticOrder, true, true>(lds, g, S, E, wave_s); }
                else { EpiBf16 E{O, DM, O, DM, 1 << 30}; pg8::gemm_phase<EpiBf16, pg8::StaticOrder, true, true>(lds, g, S, E, wave_s); }
            }
            SEAM_G(pb + 5);
            if (IN(pb + 6)) {
                pg8::Gemm g{O, (const bf16*)(ws + WS_WAO + j * ATT_W_STRIDE), M, DM, DM, DM, DM, 0}; pg8::StaticOrder S; S.init(M, DM, G, (int)blockIdx.x);
                constexpr int AES = FP8_AO ? 1 : 2; const float cs = FP8_AO ? 1.0f / 512.0f : 1.0f;
                EpiResX8 E{HB, rss_mlp, nullptr, cs, ws + WS_X8, rss_mix}; pg8::gemm_phase<EpiResX8, pg8::StaticOrder, true, true, PG8_LAYOUT8, AES>(lds, g, S, E, wave_s);
            }
            SEAM_G(pb + 6);
            pm = pb + 8;
        }
        bf16* A1 = (bf16*)(ws + (GROUP_SEAMS ? ((i & 1) ? WS_QLAT : WS_BIG + 256 * MiB) : WS_A1));
        if (IN(pm)) {
            pg8::Gemm g{(const bf16*)(ws + WS_X8), (const bf16*)(ws + WS_W1 + i * W1_STRIDE), M, FF, DM, DM, DM, 0}; pg8::StaticOrder S; S.init(M, FF, G, (int)blockIdx.x);
            LAS unsigned char* rcache = lds + 131072 + wave_s * 2304;
            *(LAS int*)(rcache + 2048) = -1;
            EpiRelu2H8 E{(unsigned char*)A1, FF, rss_mlp, rss_mix, SBW + i, rcache};
            pg8::gemm_phase<EpiRelu2H8, pg8::StaticOrder, true, true, PG8_LAYOUT8, 1, true>(lds, g, S, E, wave_s);
        }
        SEAM_G(pm);
        if (IN(pm + 1)) {
            pg8::Gemm g{A1, (const bf16*)(ws + WS_W2 + i * W2_STRIDE), M, DM, FF, FF, FF, 0}; pg8::StaticOrder S; S.init(M, DM, G, (int)blockIdx.x);
            if (i + 1 < DEPTH) { EpiResI E{HB, rss_next, nullptr, 1.0f, ws + WS_X8, rss_mlp, nullptr, COLSUM + i * DM, SBW + 4 + i};
                pg8::gemm_phase<EpiResI, pg8::StaticOrder, true, true, PG8_LAYOUT8, 1, true>(lds, g, S, E, wave_s); }
            else { EpiResIL E{HB, rss_next, nullptr, 1.0f, nullptr, nullptr, nullptr, COLSUM + i * DM, SBW + 4 + i};
                pg8::gemm_phase<EpiResIL, pg8::StaticOrder, true, true, PG8_LAYOUT8, 1, true>(lds, g, S, E, wave_s); }
        }
        if (i + 1 < DEPTH) SEAM(pm + 1); else SEAM_G(pm + 1);
    }

    if (IN(PH_FINAL)) {
        PHASE_IDS;
        const rss_t* rss = RSS + (size_t)8 * M;
        const int gwl = (int)(blockIdx.x >> 3) * NWAVES + wave, rbase = GROUP_SEAMS ? 4096 * (int)(blockIdx.x & 7) : 0, rstep = GROUP_SEAMS ? 256 : NGW, r0 = GROUP_SEAMS ? gwl : gw, rend = GROUP_SEAMS ? 4096 : M;
        for (int m0 = rbase + r0; m0 < rbase + rend; m0 += 2 * rstep) {
            v4u hw[2][4]; float rs[2];
#pragma unroll
            for (int rr = 0; rr < 2; ++rr) { const int m = m0 + rr * rstep; rs[rr] = rstd_of(rss, m); const v4u* hr = (const v4u*)(HB + (size_t)m * DM) + lane;
#pragma unroll
                for (int jj = 0; jj < 4; ++jj) hw[rr][jj] = hr[64 * jj]; }
#pragma unroll
            for (int rr = 0; rr < 2; ++rr) { const int m = m0 + rr * rstep; f32x4* orow = (f32x4*)(args.out + (size_t)m * DM); const f32x4* gr = (const f32x4*)final_norm; const float r1 = rs[rr];
#pragma unroll
                for (int jj = 0; jj < 4; ++jj) { const v4u w4 = hw[rr][jj]; const int c = (64 * jj + lane) * 2; const f32x4 g0 = gr[c], g1 = gr[c + 1];
                    orow[c] = (f32x4){bflo(w4[0]) * r1 * g0[0], bfhi(w4[0]) * r1 * g0[1], bflo(w4[1]) * r1 * g0[2], bfhi(w4[1]) * r1 * g0[3]};
                    orow[c + 1] = (f32x4){bflo(w4[2]) * r1 * g1[0], bfhi(w4[2]) * r1 * g1[1], bflo(w4[3]) * r1 * g1[2], bfhi(w4[3]) * r1 * g1[3]}; } }
        }
    }
#undef IN
#undef SEAM
}

extern "C" void kernel_launch(void* const* d_in, const int* in_sizes, int n_in, void* d_out, int out_size, void* d_ws, size_t ws_size, hipStream_t stream) {
    static int grid = 0; static bool one_launch = false;
    if (grid == 0) {
        if (n_in != 19 || out_size != M * DM || ws_size < WS_END) { fprintf(stderr, "kernel_launch: unexpected shapes (n_in %d out %d ws %zu)\n", n_in, out_size, ws_size); grid = -1; return; }
        int dev = 0, cus = 0, per_cu = 0;
        if (hipGetDevice(&dev) != hipSuccess || hipDeviceGetAttribute(&cus, hipDeviceAttributeMultiprocessorCount, dev) != hipSuccess) { grid = -1; return; }
        if (hipFuncSetAttribute((const void*)fwd, hipFuncAttributeMaxDynamicSharedMemorySize, LDS_BYTES) != hipSuccess) { fprintf(stderr, "kernel_launch: hipFuncSetAttribute failed\n"); grid = -1; return; }
        if (hipOccupancyMaxActiveBlocksPerMultiprocessor(&per_cu, (const void*)fwd, NTHR, LDS_BYTES) != hipSuccess || per_cu < 1) fprintf(stderr, "kernel_launch: occupancy query says %d\n", per_cu);
        (void)hipGetLastError();
        grid = 256; one_launch = (MK_ONE_LAUNCH != 0) && (cus >= 256) && (per_cu >= 1);
    }
    if (grid < 0) return;
    if (hipMemsetAsync((char*)d_ws + WS_CTL, 0, CTL_ZERO_BYTES, stream) != hipSuccess) return;
    Args a{};
    for (int i = 0; i < 19; ++i) a.in[i] = (const float*)d_in[i];
    a.out = (float*)d_out; a.ws = (unsigned char*)d_ws;
    if (one_launch) {
        a.ph_lo = 0; a.ph_hi = N_PHASES;
        hipLaunchKernelGGL(fwd, dim3(grid), dim3(NTHR), LDS_BYTES, stream, a);
    } else {
        for (int p = 0; p < N_PHASES; ++p) {
            const int q = (p - 1) % PH_PER_PAIR;
            if (p >= 1 && p < PH_FINAL && (q == 12 || q == 6 || q == 9)) continue;
            a.ph_lo = p; a.ph_hi = p + 1;
            hipLaunchKernelGGL(fwd, dim3(grid), dim3(NTHR), LDS_BYTES, stream, a);
        }
    }
}
```
